# Optimizing an MI355X kernel written in HIP

```python
import jax, jax.numpy as jnp
from jax import lax
import numpy as np

D_MODEL = 2048
BATCH = 4
SEQ = 8192
DEPTH = 1

POOL_WINDOWS = (2, 4, 8, 16)
POOL_GROUPS = 4
POOL_WIDTH = D_MODEL // 2
POOL_GROUP_DIM = POOL_WIDTH // POOL_GROUPS
GLA_HEADS = 4
GLA_KEY_DIM = D_MODEL // 2
GLA_VALUE_DIM = D_MODEL
GLA_HEAD_K = GLA_KEY_DIM // GLA_HEADS
GLA_HEAD_V = GLA_VALUE_DIM // GLA_HEADS
GLA_GATE_RANK = 16
GLA_GATE_TAU = 16.0
GLA_CHUNK = 64
D_FF = -(-8 * D_MODEL // (3 * 256)) * 256
N_BRANCHES = 2
EPS = 1e-6
IN_SIZES = (POOL_WIDTH, GLA_KEY_DIM, GLA_KEY_DIM, GLA_VALUE_DIM, GLA_GATE_RANK, GLA_VALUE_DIM, N_BRANCHES * D_MODEL)
D_IN = sum(IN_SIZES)

kernel_name = "hybrid_pool_gla_gated_block"


def rms_norm(x, g):
    xf = x.astype(jnp.float32)
    y = xf * lax.rsqrt(jnp.mean(xf * xf, axis=-1, keepdims=True) + EPS)
    return (y * g.astype(jnp.float32)).astype(x.dtype)


def split_combined(z):
    idx = [int(i) for i in np.cumsum(IN_SIZES)[:-1]]
    return jnp.split(z, idx, axis=-1)


def pool_mixer(p, w_pool, pool_scale):
    B, T, _ = p.shape
    pg = p.reshape(B, T, POOL_GROUPS, POOL_GROUP_DIM).astype(jnp.float32)
    cs = jnp.concatenate([jnp.zeros((B, 1, POOL_GROUPS, POOL_GROUP_DIM), jnp.float32),
                          jnp.cumsum(pg, axis=1)], axis=1)
    pos = jnp.arange(T)
    outs = []
    for g, w in enumerate(POOL_WINDOWS):
        c = cs[:, :, g]
        lo = jnp.maximum(pos + 1 - w, 0)
        win_sum = c[:, 1:] - jnp.take(c, lo, axis=1)
        count = (pos + 1 - lo).astype(jnp.float32)
        outs.append(win_sum / count[None, :, None] - pg[:, :, g])
    d = jnp.stack(outs, axis=2).astype(p.dtype)
    y = jnp.einsum('btgc,gcd->btgd', d, w_pool).reshape(B, T, POOL_WIDTH)
    return y * pool_scale


def gla_chunked(q, k, v, log_a):
    B, T, H, dk = q.shape
    dv = v.shape[-1]
    nC = T // GLA_CHUNK
    C = GLA_CHUNK

    def chunks(t):
        return t.astype(jnp.float32).reshape(B, nC, C, H, t.shape[-1]).transpose(1, 0, 3, 2, 4)

    qc = chunks(q) * (dk ** -0.5)
    kc, vc = chunks(k), chunks(v)
    Gc = jnp.cumsum(chunks(log_a), axis=3)
    mask = jnp.tril(jnp.ones((C, C), dtype=bool))

    def step(S, inp):
        qi, ki, vi, Gi = inp
        o_inter = jnp.einsum('bhik,bhkv->bhiv', qi * jnp.exp(Gi), S)
        diff = Gi[:, :, :, None, :] - Gi[:, :, None, :, :]
        decay = jnp.exp(jnp.where(mask[:, :, None], diff, -jnp.inf))
        A = jnp.einsum('bhik,bhjk,bhijk->bhij', qi, ki, decay)
        o_intra = jnp.einsum('bhij,bhjv->bhiv', A, vi)
        G_last = Gi[:, :, -1]
        k_dec = ki * jnp.exp(G_last[:, :, None] - Gi)
        S_new = jnp.exp(G_last)[..., None] * S + jnp.einsum('bhjk,bhjv->bhkv', k_dec, vi)
        return S_new, o_inter + o_intra

    S0 = jnp.zeros((B, H, dk, dv), jnp.float32)
    _, o = lax.scan(step, S0, (qc, kc, vc, Gc))
    return o.transpose(1, 0, 3, 2, 4).reshape(B, T, H, dv).astype(v.dtype)


def setup_inputs(seed: int = 0) -> dict:
    key = jax.random.key(seed)
    ks = jax.random.split(key, 20)
    f32 = jnp.float32
    L = DEPTH

    def nrm(k, shape, fan_in):
        return jax.random.normal(k, shape, f32) * (fan_in ** -0.5)

    def gain(k, shape):
        return 1.0 + 0.05 * jax.random.normal(k, shape, f32)

    return {
        "x": jax.random.normal(ks[0], (BATCH, SEQ, D_MODEL), f32),
        "norm_mix_pre": gain(ks[1], (L, D_MODEL)),
        "w_in": nrm(ks[2], (L, D_MODEL, D_IN), D_MODEL),
        "w_gate_up": nrm(ks[3], (L, GLA_GATE_RANK, GLA_KEY_DIM), GLA_GATE_RANK),
        "b_gate": 0.1 * jax.random.normal(ks[4], (L, GLA_KEY_DIM), f32),
        "w_pool": nrm(ks[5], (L, POOL_GROUPS, POOL_GROUP_DIM, POOL_GROUP_DIM), POOL_GROUP_DIM),
        "pool_scale": gain(ks[6], (L, POOL_WIDTH)),
        "gla_norm": gain(ks[7], (L, GLA_HEAD_V)),
        "w_branch_a": nrm(ks[8], (L, POOL_WIDTH, D_MODEL), POOL_WIDTH),
        "w_branch_b": nrm(ks[9], (L, GLA_VALUE_DIM, D_MODEL), GLA_VALUE_DIM),
        "b_branch_gates": 0.01 * jax.random.normal(ks[10], (L, N_BRANCHES, D_MODEL), f32),
        "w_out": nrm(ks[11], (L, D_MODEL, D_MODEL), D_MODEL),
        "norm_mix_post": gain(ks[12], (L, D_MODEL)),
        "norm_ffn_pre": gain(ks[13], (L, D_MODEL)),
        "w_ffn_gate": nrm(ks[14], (L, D_MODEL, D_FF), D_MODEL),
        "w_ffn_up": nrm(ks[15], (L, D_MODEL, D_FF), D_MODEL),
        "w_ffn_down": nrm(ks[16], (L, D_FF, D_MODEL), D_FF),
        "norm_ffn_post": gain(ks[17], (L, D_MODEL)),
    }


def reference(x, norm_mix_pre, w_in, w_gate_up, b_gate, w_pool, pool_scale, gla_norm,
              w_branch_a, w_branch_b, b_branch_gates, w_out, norm_mix_post,
              norm_ffn_pre, w_ffn_gate, w_ffn_up, w_ffn_down, norm_ffn_post):
    B, T, _ = x.shape
    for l in range(DEPTH):
        h = rms_norm(x, norm_mix_pre[l])
        z = h @ w_in[l]
        p, q, k, v, g_lr, r, gate_logits = split_combined(z)
        y_a = pool_mixer(p, w_pool[l], pool_scale[l]) @ w_branch_a[l]
        log_a = jax.nn.log_sigmoid((g_lr @ w_gate_up[l] + b_gate[l]).astype(jnp.float32)) / GLA_GATE_TAU
        o = gla_chunked(q.reshape(B, T, GLA_HEADS, GLA_HEAD_K),
                        k.reshape(B, T, GLA_HEADS, GLA_HEAD_K),
                        v.reshape(B, T, GLA_HEADS, GLA_HEAD_V),
                        log_a.reshape(B, T, GLA_HEADS, GLA_HEAD_K))
        o = rms_norm(o, gla_norm[l]).reshape(B, T, GLA_VALUE_DIM) * jax.nn.silu(r)
        y_b = o @ w_branch_b[l]
        gates = jax.nn.sigmoid(gate_logits.reshape(B, T, N_BRANCHES, D_MODEL) + b_branch_gates[l])
        mixed = (gates[:, :, 0] * y_a + gates[:, :, 1] * y_b) @ w_out[l]
        x = x + rms_norm(mixed, norm_mix_post[l])
        h = rms_norm(x, norm_ffn_pre[l])
        f = (jax.nn.silu(h @ w_ffn_gate[l]) * (h @ w_ffn_up[l])) @ w_ffn_down[l]
        x = x + rms_norm(f, norm_ffn_post[l])
    return x
```

```cpp
#include <hip/hip_runtime.h>
#include <hip/hip_cooperative_groups.h>
#include <cstdio>
#include <cstdint>
namespace cg = cooperative_groups;

namespace pg8 {
#define PG8_LAS __attribute__((address_space(3)))
typedef unsigned short bf16_t;
typedef short bf16x8 __attribute__((ext_vector_type(8)));
typedef float f32x4 __attribute__((ext_vector_type(4)));
typedef unsigned u32x4 __attribute__((ext_vector_type(4)));
constexpr int BM = 256, BK = 64, HALF = 128, HTB = HALF * BK * 2  , STAGE_BYTES = 8 * HTB, NXCD = 8, WGM = 8;

__host__ __device__ __forceinline__ int lds_byte(int r, int c) { const int st = (r >> 4) * 2 + (c >> 5), rr = r & 15, cc = c & 31, ob = rr * 64 + cc * 2; return st * 1024 + (ob ^ (((ob >> 9) & 1) << 5)); }
__host__ __device__ __forceinline__ void stage_rc(int b, int& R, int& C) { const int st = b / 1024, sb = b % 1024, swz = sb ^ (((sb >> 9) & 1) << 5); R = (st >> 1) * 16 + swz / 64; C = (st & 1) * 32 + (swz % 64) / 2; }
__host__ __device__ __forceinline__ int perm32(int rho) { const int n = rho >> 4, i = rho & 15; return 8 * (i >> 2) + 4 * n + (i & 3); }

struct Unit { int pm, pn; };
struct Gemm { const bf16_t* A; const bf16_t* Bt; int lda, ldb, K; size_t apn; };
struct StaticOrder {
    int nM, nN, nwg, G, c;
    __host__ __device__ void init(int M, int N, int G_, int c_) { nM = M / BM; nN = N / BM; nwg = nM * nN; G = G_; c = c_; }
    __host__ __device__ bool next(int i, Unit& u) const {
        const long L = (long)i * G + c; if (L >= nwg) return false;
        int wgid = (int)L; { const int q = nwg / NXCD, r = nwg % NXCD, xcd = wgid % NXCD, off = wgid / NXCD; wgid = (xcd < r ? xcd * (q + 1) : r * (q + 1) + (xcd - r) * q) + off; }
        const int nig = WGM * nN, gid = wgid / nig, fm = gid * WGM, gsz = (nM - fm) < WGM ? (nM - fm) : WGM;
        u.pm = fm + ((wgid % nig) % gsz); u.pn = (wgid % nig) / gsz; return true;
    }
    __device__ __forceinline__ void a_ready(const Unit&) const {}
    __device__ __forceinline__ void done(const Unit&) const {}
};
__device__ __forceinline__ unsigned cvt_pk_bf16(float lo, float hi) { unsigned r; asm volatile("v_cvt_pk_bf16_f32 %0, %1, %2" : "=v"(r) : "v"(lo), "v"(hi)); return r; }
template <class Epi, class Sched, bool ALIGN_EPI = false, bool SP2 = false>
__device__ __forceinline__ void gemm_phase(PG8_LAS unsigned char* lds, const Gemm g, const Sched& S, const Epi& E, const int tid_in) {
    const int tid = tid_in, wid = __builtin_amdgcn_readfirstlane(tid >> 6), lane = tid & 63, wr = wid >> 2, wc = wid & 3, fr = lane & 15, fq = lane >> 4;
    const int K = g.K, nt = K / BK;
    unsigned voffA[2], voffB[2];
#pragma unroll
    for (int i = 0; i < 2; ++i) { int R, C; stage_rc(tid * 16 + i * 8192, R, C); const int Rb = Epi::PERM ? ((R & ~31) + perm32(R & 31)) : R;
        voffA[i] = (unsigned)(R * g.lda + C) * 2u; voffB[i] = (unsigned)(Rb * g.ldb + C) * 2u; }
    const size_t kstep = (size_t)(BK * 2);
    const size_t hstepA = (size_t)HALF * g.lda * 2, hstepB = (size_t)HALF * g.ldb * 2;
    const size_t tstepA = 2 * hstepA, tstepB = 2 * hstepB;
    const unsigned ldsw = (unsigned)wid * 1024u;
    const int aoff = lds_byte(wr * 64 + fr, fq * 8), boff = lds_byte(wc * 32 + fr, fq * 8);
#define PG8_SA(b, h) (((b) * 2 + (h)) * HTB)
#define PG8_SB(b, h) ((4 + (b) * 2 + (h)) * HTB)
#define PG8_STAGE(bufoff, gbase, voff) do { _Pragma("unroll") for (int _i = 0; _i < 2; ++_i) \
        __builtin_amdgcn_global_load_lds((const unsigned*)((const char*)(gbase) + (voff)[_i]), (PG8_LAS unsigned*)(lds + (bufoff) + ldsw + _i * 8192), 16, 0, 0); } while (0)
#define PG8_LDA(dst, b, h) do { _Pragma("unroll") for (int m = 0; m < 4; ++m) _Pragma("unroll") for (int k = 0; k < 2; ++k) dst[m][k] = *(const PG8_LAS bf16x8*)(lds + PG8_SA(b, h) + aoff + m * 2048 + k * 1024); } while (0)
#define PG8_LDB(dst, b, h) do { _Pragma("unroll") for (int n = 0; n < 2; ++n) _Pragma("unroll") for (int k = 0; k < 2; ++k) dst[n][k] = *(const PG8_LAS bf16x8*)(lds + PG8_SB(b, h) + boff + n * 2048 + k * 1024); } while (0)
#define PG8_MMA(ai, bj, At, Bt) do { __builtin_amdgcn_s_setprio(1); _Pragma("unroll") for (int m = 0; m < 4; ++m) _Pragma("unroll") for (int n = 0; n < 2; ++n) _Pragma("unroll") for (int k = 0; k < 2; ++k) \
        acc[ai][bj][m][n] = __builtin_amdgcn_mfma_f32_16x16x32_bf16(Bt[n][k], At[m][k], acc[ai][bj][m][n], 0, 0, 0); __builtin_amdgcn_s_setprio(0); } while (0)
#define PG8_WAIT_V(n) asm volatile("s_waitcnt vmcnt(" #n ")" ::: "memory")
#define PG8_WAIT_L(n) asm volatile("s_waitcnt lgkmcnt(" #n ")" ::: "memory")
#define PG8_BAR __builtin_amdgcn_s_barrier()
#define PG8_SCHED __builtin_amdgcn_sched_barrier(0)
    Unit cur, nxt; int ui = 0;
    if (!S.next(0, cur)) return;
    f32x4 acc[2][2][4][2];
#pragma unroll
    for (int a = 0; a < 2; ++a)
#pragma unroll
        for (int b = 0; b < 2; ++b)
#pragma unroll
            for (int m = 0; m < 4; ++m)
#pragma unroll
                for (int n = 0; n < 2; ++n) acc[a][b][m][n] = (f32x4){0.f, 0.f, 0.f, 0.f};
    bf16x8 At[4][2], B0[2][2], B1[2][2];
    const char* cA = (const char*)g.A + (size_t)cur.pm * tstepA + (size_t)cur.pn * g.apn; const char* cB = (const char*)g.Bt + (size_t)cur.pn * tstepB;
    S.a_ready(cur);
    if constexpr (SP2) {
        PG8_STAGE(PG8_SB(0, 0), cB, voffB); PG8_STAGE(PG8_SB(0, 1), cB + hstepB, voffB); PG8_STAGE(PG8_SA(0, 0), cA, voffA); PG8_STAGE(PG8_SA(0, 1), cA + hstepA, voffA);
        if (wr == 1) PG8_BAR;
        PG8_WAIT_V(2); PG8_BAR;
        PG8_STAGE(PG8_SB(1, 0), cB + kstep, voffB); PG8_STAGE(PG8_SA(1, 0), cA + kstep, voffA); PG8_STAGE(PG8_SB(1, 1), cB + hstepB + kstep, voffB);
        PG8_WAIT_V(6); PG8_BAR;
    } else {
        PG8_STAGE(PG8_SB(0, 0), cB, voffB); PG8_STAGE(PG8_SA(0, 0), cA, voffA); PG8_STAGE(PG8_SB(0, 1), cB + hstepB, voffB); PG8_STAGE(PG8_SA(0, 1), cA + hstepA, voffA);
        if (wr == 1) PG8_BAR;
        PG8_WAIT_V(4); PG8_BAR;
        PG8_STAGE(PG8_SB(1, 0), cB + kstep, voffB); PG8_STAGE(PG8_SA(1, 0), cA + kstep, voffA); PG8_STAGE(PG8_SB(1, 1), cB + hstepB + kstep, voffB);
        PG8_WAIT_V(6); PG8_BAR;
    }
    for (;;) {
        const bool has_next = S.next(ui + 1, nxt);
        const char* nA = has_next ? (const char*)g.A + (size_t)nxt.pm * tstepA + (size_t)nxt.pn * g.apn : cA; const char* nB = has_next ? (const char*)g.Bt + (size_t)nxt.pn * tstepB : cB;
        for (int t = 0; t < nt; t += 2) {
            const bool last = (t == nt - 2);
            const char* a1 = cA + (size_t)(t + 1) * kstep;
            const char* a2 = last ? nA : cA + (size_t)(t + 2) * kstep; const char* b2 = last ? nB : cB + (size_t)(t + 2) * kstep;
            const char* a3 = a2 + kstep; const char* b3 = b2 + kstep;
            if (last && has_next) S.a_ready(nxt);
            if constexpr (SP2) {
            PG8_LDB(B0, 0, 0); PG8_LDB(B1, 0, 1); PG8_SCHED; PG8_LDA(At, 0, 0); PG8_STAGE(PG8_SA(1, 1), a1 + hstepA, voffA);
            PG8_WAIT_V(8); PG8_WAIT_L(0); PG8_BAR; PG8_MMA(0, 0, At, B0); PG8_MMA(0, 1, At, B1); PG8_BAR; PG8_SCHED;
            PG8_LDA(At, 0, 1); PG8_STAGE(PG8_SB(0, 0), b2, voffB); PG8_STAGE(PG8_SB(0, 1), b2 + hstepB, voffB); PG8_STAGE(PG8_SA(0, 0), a2, voffA);
            PG8_WAIT_V(8); PG8_WAIT_L(0); PG8_BAR; PG8_MMA(1, 0, At, B0); PG8_MMA(1, 1, At, B1); PG8_BAR; PG8_SCHED;
            PG8_LDB(B0, 1, 0); PG8_LDB(B1, 1, 1); PG8_SCHED; PG8_LDA(At, 1, 0); PG8_STAGE(PG8_SA(0, 1), a2 + hstepA, voffA);
            PG8_WAIT_V(8); PG8_WAIT_L(0); PG8_BAR; PG8_MMA(0, 0, At, B0); PG8_MMA(0, 1, At, B1); PG8_BAR; PG8_SCHED;
            PG8_LDA(At, 1, 1); PG8_STAGE(PG8_SB(1, 0), b3, voffB); PG8_STAGE(PG8_SB(1, 1), b3 + hstepB, voffB); PG8_STAGE(PG8_SA(1, 0), a3, voffA);
            PG8_WAIT_V(8); PG8_WAIT_L(0); PG8_BAR; PG8_MMA(1, 0, At, B0); PG8_MMA(1, 1, At, B1); PG8_BAR; PG8_SCHED;
            } else {
            PG8_LDB(B0, 0, 0); PG8_SCHED; PG8_LDA(At, 0, 0); PG8_STAGE(PG8_SA(1, 1), a1 + hstepA, voffA);
            PG8_WAIT_L(8); PG8_BAR; PG8_WAIT_L(0); PG8_MMA(0, 0, At, B0); PG8_BAR; PG8_SCHED;
            PG8_LDB(B1, 0, 1); PG8_STAGE(PG8_SB(0, 0), b2, voffB);
            PG8_BAR; PG8_WAIT_L(0); PG8_MMA(0, 1, At, B1); PG8_BAR;
            PG8_LDA(At, 0, 1); PG8_STAGE(PG8_SA(0, 0), a2, voffA);
            PG8_BAR; PG8_WAIT_L(0); PG8_MMA(1, 0, At, B0); PG8_BAR; PG8_SCHED;
            PG8_STAGE(PG8_SB(0, 1), b2 + hstepB, voffB);
            PG8_WAIT_V(6); PG8_BAR; PG8_MMA(1, 1, At, B1); PG8_BAR;
            PG8_LDB(B0, 1, 0); PG8_SCHED; PG8_LDA(At, 1, 0); PG8_STAGE(PG8_SA(0, 1), a2 + hstepA, voffA);
            PG8_WAIT_L(8); PG8_BAR; PG8_WAIT_L(0); PG8_MMA(0, 0, At, B0); PG8_BAR; PG8_SCHED;
            PG8_LDB(B1, 1, 1); PG8_STAGE(PG8_SB(1, 0), b3, voffB);
            PG8_BAR; PG8_WAIT_L(0); PG8_MMA(0, 1, At, B1); PG8_BAR;
            PG8_LDA(At, 1, 1); PG8_STAGE(PG8_SA(1, 0), a3, voffA);
            PG8_BAR; PG8_WAIT_L(0); PG8_MMA(1, 0, At, B0); PG8_BAR; PG8_SCHED;
            PG8_STAGE(PG8_SB(1, 1), b3 + hstepB, voffB);
            PG8_WAIT_V(6); PG8_BAR; PG8_MMA(1, 1, At, B1); PG8_BAR;
            }
        }
        if constexpr (ALIGN_EPI) { if (wr == 0) PG8_BAR; }
        if constexpr (!Epi::AFTER_DRAIN) { E(acc, cur, wr, wc, fr, fq); S.done(cur); }
        if (!has_next) break;
#pragma unroll
        for (int a = 0; a < 2; ++a)
#pragma unroll
            for (int b = 0; b < 2; ++b)
#pragma unroll
                for (int m = 0; m < 4; ++m)
#pragma unroll
                    for (int n = 0; n < 2; ++n) acc[a][b][m][n] = (f32x4){0.f, 0.f, 0.f, 0.f};
        cur = nxt; cA = nA; cB = nB; ++ui;
        if constexpr (ALIGN_EPI) { if (wr == 1) PG8_BAR; }
    }
    PG8_WAIT_V(0);
    if constexpr (!ALIGN_EPI) { if (wr == 0) PG8_BAR; }
    PG8_BAR;
    if constexpr (Epi::AFTER_DRAIN) { E.fused(acc, cur, wr, wc, fr, fq, lds, wid, lane); S.done(cur); }
#undef PG8_SA
#undef PG8_SB
#undef PG8_STAGE
#undef PG8_LDA
#undef PG8_LDB
#undef PG8_MMA
#undef PG8_WAIT_V
#undef PG8_WAIT_L
#undef PG8_BAR
#undef PG8_SCHED
}
}


#define LAS __attribute__((address_space(3)))
typedef unsigned short bf16;
typedef unsigned v4u __attribute__((ext_vector_type(4)));
typedef unsigned v2u __attribute__((ext_vector_type(2)));
using pg8::f32x4; using pg8::bf16x8; using pg8::Unit;
#define LDS_WAIT() asm volatile("s_waitcnt lgkmcnt(0)" ::: "memory")
#define BAR_LDS() do { asm volatile("s_waitcnt lgkmcnt(0)" ::: "memory"); __builtin_amdgcn_s_barrier(); asm volatile("" ::: "memory"); } while (0)

constexpr int NB = 4, T = 8192, D = 2048, M = NB * T;
constexpr int PW = 1024, KD = 1024, VD = 2048, HK = 256, HV = 512, FF = 5632, DIN = 11280, NZ = 11264, NGU = 11264, NCH = 128;
constexpr float EPS = 1e-6f;
constexpr int LDS_BYTES = 147456;
constexpr size_t MiB = 1u << 20;
constexpr size_t WS_WIN = 0, WS_WGU = 44 * MiB, WS_WD = 88 * MiB, WS_WB = 110 * MiB, WS_WOUT = 118 * MiB, WS_WA = 126 * MiB, WS_WP = 130 * MiB,
                 WS_GLR = 131 * MiB, WS_XN = 133 * MiB, WS_Z = 261 * MiB;
constexpr size_t Z_P = WS_Z, Z_Q = Z_P + 64 * MiB, Z_K = Z_Q + 64 * MiB, Z_V = Z_K + 64 * MiB, Z_R = Z_V + 128 * MiB, Z_G = Z_R + 128 * MiB, WS_END = Z_G + 256 * MiB;
constexpr size_t WS_CTL = WS_END, CTL_BYTES = 4096, WS_NEED = WS_END + CTL_BYTES;
constexpr int LDS_CTL = 131072 + 1024;
constexpr size_t WS_KDT = WS_XN, WS_QP = WS_XN + 64 * MiB, WS_T = WS_XN, WS_MIX = Z_Q, WS_U = WS_XN, WS_H2 = Z_G, WS_F = WS_Z, WS_FO = WS_Z + 352 * MiB;
constexpr size_t DO_DIFF = 0, DO_AMAT = 64 * MiB, DO_AVEC = 80 * MiB, DO_O = 96 * MiB;

struct Args { const float* in[18]; float* out; unsigned char* ws; };

__device__ __forceinline__ float bflo(unsigned u) { return __uint_as_float(u << 16); }
__device__ __forceinline__ float bfhi(unsigned u) { return __uint_as_float(u & 0xffff0000u); }
typedef float f32x2_t __attribute__((ext_vector_type(2)));
typedef __bf16 bf16x2_t __attribute__((ext_vector_type(2)));
__device__ __forceinline__ unsigned pk_c(float lo, float hi) { f32x2_t v = {lo, hi}; bf16x2_t b = __builtin_convertvector(v, bf16x2_t); return __builtin_bit_cast(unsigned, b); }
__device__ __forceinline__ unsigned pk(float lo, float hi) { return pg8::cvt_pk_bf16(lo, hi); }
__device__ __forceinline__ float sigm(float x) { return 1.f / (1.f + __expf(-x)); }
__device__ __forceinline__ float silu(float x) { return x / (1.f + __expf(-x)); }
__device__ __forceinline__ float wave_sum(float v) {
#pragma unroll
    for (int o = 1; o < 64; o <<= 1) v += __shfl_xor(v, o);
    return v;
}
__device__ __forceinline__ void unpack8(const v4u u, float (&f)[8]) {
    f[0] = bflo(u.x); f[1] = bfhi(u.x); f[2] = bflo(u.y); f[3] = bfhi(u.y); f[4] = bflo(u.z); f[5] = bfhi(u.z); f[6] = bflo(u.w); f[7] = bfhi(u.w);
}
__device__ __forceinline__ v4u pack8(const float (&f)[8]) { v4u u; u.x = pk(f[0], f[1]); u.y = pk(f[2], f[3]); u.z = pk(f[4], f[5]); u.w = pk(f[6], f[7]); return u; }

enum { E_Z = 0, E_POOL = 1, E_YA = 2, E_YB = 3, E_PLAIN = 4, E_SWIGLU = 5 };
template <int MODE> struct Epi {
    static constexpr bool PERM = true, AFTER_DRAIN = false;
    bf16* O; int ldc;
    const bf16* Gt;
    const bf16* Tin;
    const float* vec;
    bf16 *zP, *zQ, *zK, *zV, *zR, *zG;
    __device__ __forceinline__ void operator()(const f32x4 (&acc)[2][2][4][2], const Unit& u, int wr, int wc, int fr, int fq) const {
        const int row0 = u.pm * 256 + wr * 64 + fr, lc = wc * 32 + 8 * fq;
        if constexpr (MODE == E_SWIGLU) {
#pragma unroll
            for (int ai = 0; ai < 2; ++ai)
#pragma unroll
                for (int m = 0; m < 4; ++m) {
                    const f32x4 g0 = acc[ai][0][m][0], g1 = acc[ai][0][m][1], u0 = acc[ai][1][m][0], u1 = acc[ai][1][m][1];
                    v4u w; w.x = pk(silu(g0[0]) * u0[0], silu(g0[1]) * u0[1]); w.y = pk(silu(g0[2]) * u0[2], silu(g0[3]) * u0[3]);
                    w.z = pk(silu(g1[0]) * u1[0], silu(g1[1]) * u1[1]); w.w = pk(silu(g1[2]) * u1[2], silu(g1[3]) * u1[3]);
                    *(v4u*)(O + (size_t)(row0 + ai * 128 + m * 16) * ldc + u.pn * 128 + lc) = w; }
        } else {
            bf16* base = O; int ld = ldc, ct = u.pn * 256, op = 0;
            if constexpr (MODE == E_Z) {
                const int pn = u.pn;
                if (pn < 4) { base = zP; ld = 1024; ct = pn * 256; }
                else if (pn < 8) { base = zQ; ld = 1024; ct = (pn - 4) * 256; op = 1; }
                else if (pn < 12) { base = zK; ld = 1024; ct = (pn - 8) * 256; }
                else if (pn < 20) { base = zV; ld = 2048; ct = (pn - 12) * 256; }
                else if (pn < 28) { base = zR; ld = 2048; ct = (pn - 20) * 256; op = 2; }
                else { base = zG; ld = 4096; ct = (pn - 28) * 256; op = 3; }
            }
#pragma unroll
            for (int bj = 0; bj < 2; ++bj) {
                const int col = ct + bj * 128 + lc;
                f32x4 s0 = {1.f, 1.f, 1.f, 1.f}, s1 = s0;
                if constexpr (MODE == E_POOL) { s0 = *(const f32x4*)(vec + col); s1 = *(const f32x4*)(vec + col + 4); }
                if constexpr (MODE == E_Z) { if (op == 3) { s0 = *(const f32x4*)(vec + col); s1 = *(const f32x4*)(vec + col + 4); } }
#pragma unroll
                for (int ai = 0; ai < 2; ++ai)
#pragma unroll
                    for (int m = 0; m < 4; ++m) {
                        const size_t row = (size_t)(row0 + ai * 128 + m * 16);
                        f32x4 v0 = acc[ai][bj][m][0], v1 = acc[ai][bj][m][1];
                        if constexpr (MODE == E_POOL) { v0 = v0 * s0; v1 = v1 * s1; }
                        if constexpr (MODE == E_Z) {
                            if (op == 1) { v0 = v0 * 0.0625f; v1 = v1 * 0.0625f; }
                            else if (op == 2) { for (int i = 0; i < 4; ++i) { v0[i] = silu(v0[i]); v1[i] = silu(v1[i]); } }
                            else if (op == 3) { for (int i = 0; i < 4; ++i) { v0[i] = sigm(v0[i] + s0[i]); v1[i] = sigm(v1[i] + s1[i]); } }
                        }
                        if constexpr (MODE == E_YA || MODE == E_YB) {
                            float g[8]; unpack8(*(const v4u*)(Gt + row * 4096 + col), g);
                            for (int i = 0; i < 4; ++i) { v0[i] *= g[i]; v1[i] *= g[4 + i]; }
                            if constexpr (MODE == E_YB) { float t[8]; unpack8(*(const v4u*)(Tin + row * ld + col), t); for (int i = 0; i < 4; ++i) { v0[i] += t[i]; v1[i] += t[4 + i]; } }
                        }
                        v4u w; w.x = pk(v0[0], v0[1]); w.y = pk(v0[2], v0[3]); w.z = pk(v1[0], v1[1]); w.w = pk(v1[2], v1[3]);
                        *(v4u*)(base + row * ld + col) = w; }
            }
        }
    }
};

__device__ __forceinline__ void transpose_item(const float* W, int ldw, int K, int k0, int ns0, bf16* WT, int nd0, LAS float* scr, int lane) {
    float rr[32];
    const float* wp = W + (size_t)(k0 + (lane >> 5)) * ldw + ns0 + (lane & 31);
#pragma unroll
    for (int i = 0; i < 32; ++i) rr[i] = wp[(size_t)(2 * i) * ldw];
#pragma unroll
    for (int i = 0; i < 32; ++i) scr[(2 * i + (lane >> 5)) * 33 + (lane & 31)] = rr[i];
    LDS_WAIT(); asm volatile("" ::: "memory");
    const int c = lane & 7;
#pragma unroll
    for (int j = 0; j < 4; ++j) { const int n = (lane >> 3) + 8 * j; const LAS float* s = scr + (8 * c) * 33 + n;
        v4u o; o.x = pk(s[0 * 33], s[1 * 33]); o.y = pk(s[2 * 33], s[3 * 33]); o.z = pk(s[4 * 33], s[5 * 33]); o.w = pk(s[6 * 33], s[7 * 33]);
        *(v4u*)(WT + (size_t)(nd0 + n) * K + k0 + 8 * c) = o; }
    LDS_WAIT(); asm volatile("" ::: "memory");
}

__device__ __forceinline__ void phase0(const Args& a, LAS unsigned char* lds, int tid, int lane, int wave, int G) {
    unsigned char* ws = a.ws;
    LAS float* scr = (LAS float*)(lds + wave * 16384);
    const int gw = blockIdx.x * 8 + wave, NGW = G * 8;
    constexpr int I_IN = 32 * 352, I_GU = 32 * 176, I_D = 88 * 64, I_SQ = 32 * 64, I_A = 16 * 64, I_P = 4 * 4 * 8;
    constexpr int NITEMS = I_IN + 2 * I_GU + I_D + 2 * I_SQ + I_A + I_P;
    for (int it = gw; it < NITEMS; it += NGW) {
        int r = it;
        if (r < I_IN) { const int kb = r / 352, nb = r % 352, nd0 = 32 * nb, ns0 = nd0 < 5120 ? nd0 : nd0 + 16;
            transpose_item(a.in[2], DIN, D, 64 * kb, ns0, (bf16*)(ws + WS_WIN), nd0, scr, lane); continue; } r -= I_IN;
        if (r < I_GU) { const int kb = r / 176, nb = r % 176, c = 32 * nb, nd0 = (c >> 7) * 256 + (c & 127);
            transpose_item(a.in[14], FF, D, 64 * kb, c, (bf16*)(ws + WS_WGU), nd0, scr, lane); continue; } r -= I_GU;
        if (r < I_GU) { const int kb = r / 176, nb = r % 176, c = 32 * nb, nd0 = (c >> 7) * 256 + (c & 127) + 128;
            transpose_item(a.in[15], FF, D, 64 * kb, c, (bf16*)(ws + WS_WGU), nd0, scr, lane); continue; } r -= I_GU;
        if (r < I_D) { const int kb = r / 64, nb = r % 64;
            transpose_item(a.in[16], D, FF, 64 * kb, 32 * nb, (bf16*)(ws + WS_WD), 32 * nb, scr, lane); continue; } r -= I_D;
        if (r < I_SQ) { const int kb = r / 64, nb = r % 64;
            transpose_item(a.in[9], D, D, 64 * kb, 32 * nb, (bf16*)(ws + WS_WB), 32 * nb, scr, lane); continue; } r -= I_SQ;
        if (r < I_SQ) { const int kb = r / 64, nb = r % 64;
            transpose_item(a.in[11], D, D, 64 * kb, 32 * nb, (bf16*)(ws + WS_WOUT), 32 * nb, scr, lane); continue; } r -= I_SQ;
        if (r < I_A) { const int kb = r / 64, nb = r % 64;
            transpose_item(a.in[8], D, PW, 64 * kb, 32 * nb, (bf16*)(ws + WS_WA), 32 * nb, scr, lane); continue; } r -= I_A;
        { const int g = r / 32, rr = r % 32, kb = rr / 8, nb = rr % 8;
            transpose_item(a.in[5] + (size_t)g * 65536, 256, 256, 64 * kb, 32 * nb, (bf16*)(ws + WS_WP) + (size_t)g * 65536, 32 * nb, scr, lane); }
    }
    __syncthreads();
    LAS float* wgt = (LAS float*)lds;
    for (int e = tid; e < 2048 * 4; e += 512) { const int k = e >> 2, q4 = e & 3; const f32x4 v = *(const f32x4*)(a.in[2] + (size_t)k * DIN + 5120 + 4 * q4);
        wgt[(4 * q4 + 0) * 2048 + k] = v[0]; wgt[(4 * q4 + 1) * 2048 + k] = v[1]; wgt[(4 * q4 + 2) * 2048 + k] = v[2]; wgt[(4 * q4 + 3) * 2048 + k] = v[3]; }
    __syncthreads();
    f32x4 gn[8];
#pragma unroll
    for (int j = 0; j < 8; ++j) gn[j] = *(const f32x4*)(a.in[1] + 256 * j + 4 * lane);
    bf16* XN = (bf16*)(ws + WS_XN); float* glr = (float*)(ws + WS_GLR);
    typedef float f32x2 __attribute__((ext_vector_type(2)));
    f32x4 na[8], nb[8];
    if (gw < M / 2) {
#pragma unroll
        for (int j = 0; j < 8; ++j) { na[j] = *(const f32x4*)(a.in[0] + (size_t)(2 * gw) * D + 256 * j + 4 * lane); nb[j] = *(const f32x4*)(a.in[0] + (size_t)(2 * gw + 1) * D + 256 * j + 4 * lane); }
    }
    const int hi = lane >> 5;
    for (int pr = gw; pr < M / 2; pr += NGW) {
        const size_t ra = 2 * (size_t)pr, rb = ra + 1;
        f32x2 xab[8][4]; float ssa = 0.f, ssb = 0.f;
#pragma unroll
        for (int j = 0; j < 8; ++j) {
            const f32x4 va = na[j], vb = nb[j];
            ssa += (va[0] * va[0] + va[1] * va[1]) + (va[2] * va[2] + va[3] * va[3]); ssb += (vb[0] * vb[0] + vb[1] * vb[1]) + (vb[2] * vb[2] + vb[3] * vb[3]);
#pragma unroll
            for (int i = 0; i < 4; ++i) xab[j][i] = (f32x2){va[i] * gn[j][i], vb[i] * gn[j][i]}; }
        { const int nx = pr + NGW;
          if (nx < M / 2) {
#pragma unroll
              for (int j = 0; j < 8; ++j) { na[j] = *(const f32x4*)(a.in[0] + (size_t)(2 * nx) * D + 256 * j + 4 * lane); nb[j] = *(const f32x4*)(a.in[0] + (size_t)(2 * nx + 1) * D + 256 * j + 4 * lane); } } }
        const float rsa = rsqrtf(wave_sum(ssa) * (1.f / D) + EPS), rsb = rsqrtf(wave_sum(ssb) * (1.f / D) + EPS);
#pragma unroll
        for (int j = 0; j < 8; ++j) { v2u wa, wb; wa.x = pk(xab[j][0].x * rsa, xab[j][1].x * rsa); wa.y = pk(xab[j][2].x * rsa, xab[j][3].x * rsa); wb.x = pk(xab[j][0].y * rsb, xab[j][1].y * rsb); wb.y = pk(xab[j][2].y * rsb, xab[j][3].y * rsb);
            *(v2u*)(XN + ra * D + 256 * j + 4 * lane) = wa; *(v2u*)(XN + rb * D + 256 * j + 4 * lane) = wb; }
        float v[16];
#pragma unroll
        for (int jj = 0; jj < 16; ++jj) { f32x2 s0 = {0.f, 0.f}, s1 = {0.f, 0.f};
#pragma unroll
            for (int j = 0; j < 8; ++j) { const f32x4 w = *(const LAS f32x4*)(wgt + jj * 2048 + 256 * j + 4 * lane);
                s0 = xab[j][0] * w[0] + s0; s1 = xab[j][1] * w[1] + s1; s0 = xab[j][2] * w[2] + s0; s1 = xab[j][3] * w[3] + s1; }
            s0 = s0 + s1;
            const float mine = hi ? s0.y : s0.x, send = hi ? s0.x : s0.y;
            v[jj] = mine + __shfl_xor(send, 32); }
#pragma unroll
        for (int st = 0; st < 4; ++st) { const int n = 8 >> st, msk = 16 >> st; const bool b = (lane & msk) != 0;
#pragma unroll
            for (int i = 0; i < n; ++i) { const float mine = b ? v[i + n] : v[i], send = b ? v[i] : v[i + n]; v[i] = mine + __shfl_xor(send, msk); } }
        v[0] += __shfl_xor(v[0], 1);
        if ((lane & 1) == 0) glr[(ra + hi) * 16 + ((lane >> 1) & 15)] = v[0] * (hi ? rsb : rsa);
    }
}

template <int W> __device__ __forceinline__ void pool_block(const bf16* P, bf16* Dd, int tblk, int c8) {
    const int t0 = tblk * 8, pos0 = t0 & (T - 1);
    constexpr int R = W + 7;
    v4u rows[R];
#pragma unroll
    for (int r = 0; r < R; ++r) { const int dt = r - (W - 1); const bool valid = (pos0 + dt) >= 0;
        rows[r] = valid ? *(const v4u*)(P + (size_t)(t0 + dt) * 1024 + c8 * 8) : (v4u){0u, 0u, 0u, 0u}; }
    float s[8];
#pragma unroll
    for (int i = 0; i < 8; ++i) s[i] = 0.f;
#pragma unroll
    for (int r = 0; r < W - 1; ++r) { float f[8]; unpack8(rows[r], f);
#pragma unroll
        for (int i = 0; i < 8; ++i) s[i] += f[i]; }
#pragma unroll
    for (int o = 0; o < 8; ++o) {
        float cur[8]; unpack8(rows[o + W - 1], cur);
#pragma unroll
        for (int i = 0; i < 8; ++i) s[i] += cur[i];
        const int cnt = (pos0 + o + 1 < W) ? pos0 + o + 1 : W; const float inv = 1.f / (float)cnt;
        float d[8];
#pragma unroll
        for (int i = 0; i < 8; ++i) d[i] = s[i] * inv - cur[i];
        *(v4u*)(Dd + (size_t)(t0 + o) * 1024 + c8 * 8) = pack8(d);
        float old[8]; unpack8(rows[o], old);
#pragma unroll
        for (int i = 0; i < 8; ++i) s[i] -= old[i];
    }
}
__device__ __forceinline__ void pool_diff(const bf16* P, bf16* Dd, int lane, int wave, int G) {
    const int gw = blockIdx.x * 8 + wave, NGW = G * 8;
    for (int wi = gw; wi < 4 * (M / 16); wi += NGW) {
        const int g = (wi + (wi >> 11)) & 3, tp = wi >> 2, tblk = 2 * tp + (lane >> 5), c8 = g * 32 + (lane & 31);
        if (g == 0) pool_block<2>(P, Dd, tblk, c8); else if (g == 1) pool_block<4>(P, Dd, tblk, c8); else if (g == 2) pool_block<8>(P, Dd, tblk, c8); else pool_block<16>(P, Dd, tblk, c8);
    }
}

__device__ __forceinline__ void gla_prepass(const Args& a, LAS unsigned char* lds, int tid, int lane, int wave, int G) {
    unsigned char* ws = a.ws;
    constexpr int QS = 0, KS = 33792, WU = 67584;
    const bf16* Q = (const bf16*)(ws + Z_Q); bf16* Qp = (bf16*)(ws + WS_QP); const bf16* Kb = (const bf16*)(ws + Z_K); bf16* KdT = (bf16*)(ws + WS_KDT);
    bf16* Amat = (bf16*)((unsigned char*)a.out + DO_AMAT); float* avec = (float*)((unsigned char*)a.out + DO_AVEC);
    const float* glr = (const float*)(ws + WS_GLR);
    const int l15 = lane & 15, g4 = lane >> 4;
    for (int it = blockIdx.x; it < 2048; it += G) {
        const int bh = it >> 7, c = it & 127, b = bh >> 2, h = bh & 3; const size_t t0 = (size_t)b * T + (size_t)c * 64;
        const size_t trow = t0 + lane; const int kc0 = h * 256 + 32 * wave;
        f32x4 gl[4];
#pragma unroll
        for (int i = 0; i < 4; ++i) gl[i] = *(const f32x4*)(glr + trow * 16 + 4 * i);
        v4u qv[4], kv[4];
#pragma unroll
        for (int i = 0; i < 4; ++i) { qv[i] = *(const v4u*)(Q + trow * 1024 + kc0 + 8 * i); kv[i] = *(const v4u*)(Kb + trow * 1024 + kc0 + 8 * i); }
        for (int e = tid; e < 17 * 64; e += 512) { const int jr = e >> 6, c4 = (e & 63) * 4;
            const f32x4 v = (jr < 16) ? *(const f32x4*)(a.in[3] + jr * 1024 + h * 256 + c4) : *(const f32x4*)(a.in[4] + h * 256 + c4);
            *(LAS f32x4*)(lds + WU + (jr * 256 + c4) * 4) = v; }
        __syncthreads();
        float Gc[32];
#pragma unroll
        for (int q8 = 0; q8 < 8; ++q8) {
            f32x4 z = *(const LAS f32x4*)(lds + WU + (16 * 256 + 32 * wave + 4 * q8) * 4);
#pragma unroll
            for (int jr = 0; jr < 16; ++jr) { const f32x4 w = *(const LAS f32x4*)(lds + WU + (jr * 256 + 32 * wave + 4 * q8) * 4); z = z + w * gl[jr >> 2][jr & 3]; }
#pragma unroll
            for (int i = 0; i < 4; ++i) { const float zz = z[i]; Gc[4 * q8 + i] = (fminf(zz, 0.f) - __logf(1.f + __expf(-fabsf(zz)))) * 0.0625f; }
        }
#pragma unroll
        for (int d = 1; d < 64; d <<= 1) {
#pragma unroll
            for (int cc = 0; cc < 32; ++cc) { const float up = __shfl_up(Gc[cc], d); Gc[cc] += (lane >= d) ? up : 0.f; } }
        float kd[32]; unsigned qpk[16], kpk[16];
#pragma unroll
        for (int i = 0; i < 4; ++i) { float qf[8], kf[8]; unpack8(qv[i], qf); unpack8(kv[i], kf);
#pragma unroll
            for (int e = 0; e < 8; ++e) { const int cc = 8 * i + e; const float Gv = Gc[cc], Gl = __shfl(Gv, 63);
                const float eg = __expf(Gv), ie = __expf(-Gv);
                qf[e] = qf[e] * eg; kd[cc] = kf[e] * __expf(Gl - Gv); kf[e] = kf[e] * ie;
                if (lane == 63) Gc[cc] = eg; }
            const v4u qo = pack8(qf), ko = pack8(kf);
            *(v4u*)(Qp + trow * 1024 + kc0 + 8 * i) = qo;
            *(LAS v4u*)(lds + QS + lane * 528 + (32 * wave + 8 * i) * 2) = qo; *(LAS v4u*)(lds + KS + lane * 528 + (32 * wave + 8 * i) * 2) = ko; }
        if (lane == 63) {
#pragma unroll
            for (int i = 0; i < 8; ++i) *(f32x4*)(avec + (size_t)it * 256 + 32 * wave + 4 * i) = (f32x4){Gc[4 * i], Gc[4 * i + 1], Gc[4 * i + 2], Gc[4 * i + 3]}; }
#pragma unroll
        for (int cc = 0; cc < 32; cc += 2) { const unsigned p2 = pk(kd[cc], kd[cc + 1]);
            KdT[((size_t)it * 256 + 32 * wave + cc) * 64 + lane] = (unsigned short)(p2 & 0xffffu); KdT[((size_t)it * 256 + 32 * wave + cc + 1) * 64 + lane] = (unsigned short)(p2 >> 16); }
        __syncthreads();
        const int jt = wave >> 1, it0 = 2 * (wave & 1);
        f32x4 c0 = {0.f, 0.f, 0.f, 0.f}, c1 = c0;
#pragma unroll
        for (int kk = 0; kk < 8; ++kk) {
            const bf16x8 av = *(const LAS bf16x8*)(lds + KS + (16 * jt + l15) * 528 + (32 * kk + 8 * g4) * 2);
            const bf16x8 b0 = *(const LAS bf16x8*)(lds + QS + (16 * it0 + l15) * 528 + (32 * kk + 8 * g4) * 2);
            const bf16x8 b1 = *(const LAS bf16x8*)(lds + QS + (16 * it0 + 16 + l15) * 528 + (32 * kk + 8 * g4) * 2);
            c0 = __builtin_amdgcn_mfma_f32_16x16x32_bf16(av, b0, c0, 0, 0, 0); c1 = __builtin_amdgcn_mfma_f32_16x16x32_bf16(av, b1, c1, 0, 0, 0); }
        { const int jb = 16 * jt + 4 * g4; const int i0 = 16 * it0 + l15, i1 = i0 + 16;
          v2u w0, w1;
          w0.x = pk(jb + 0 <= i0 ? c0[0] : 0.f, jb + 1 <= i0 ? c0[1] : 0.f); w0.y = pk(jb + 2 <= i0 ? c0[2] : 0.f, jb + 3 <= i0 ? c0[3] : 0.f);
          w1.x = pk(jb + 0 <= i1 ? c1[0] : 0.f, jb + 1 <= i1 ? c1[1] : 0.f); w1.y = pk(jb + 2 <= i1 ? c1[2] : 0.f, jb + 3 <= i1 ? c1[3] : 0.f);
          *(v2u*)(Amat + (size_t)it * 4096 + i0 * 64 + jb) = w0; *(v2u*)(Amat + (size_t)it * 4096 + i1 * 64 + jb) = w1; }
        __syncthreads();
    }
}

__device__ __forceinline__ void gla_seq(const Args& a, LAS unsigned char* lds, int tid, int lane, int wave, int G, int vc) {
    unsigned char* ws = a.ws;
    constexpr int QS = 0, KT = 33792, AS = 70656, VT = 79872, ST = 84480, AV = 101376;
    const bf16* Q = (const bf16*)(ws + WS_QP); const bf16* KdT = (const bf16*)(ws + WS_KDT); const bf16* V = (const bf16*)(ws + Z_V); bf16* Ob = (bf16*)((unsigned char*)a.out + DO_O);
    const bf16* Amat = (const bf16*)((unsigned char*)a.out + DO_AMAT); const float* avec = (const float*)((unsigned char*)a.out + DO_AVEC);
    const int l15 = lane & 15, g4 = lane >> 4;
    for (int it = vc; it < 256; it += G) {
        const int vi = (it & 7) * 32 + (it >> 3), bh = vi >> 4, vs = vi & 15, b = bh >> 2, h = bh & 3;
        const size_t tb = (size_t)b * T;
        const bf16* qbase = Q + tb * 1024 + h * 256;
        const bf16* ktbase = KdT + (size_t)bh * 128 * 16384;
        const bf16* abase = Amat + (size_t)bh * 128 * 4096;
        const float* avbase = avec + (size_t)bh * 128 * 256;
        const bf16* vbase = V + tb * 2048 + h * 512 + vs * 32; bf16* obase = Ob + tb * 2048 + h * 512 + vs * 32;
        for (int e = tid; e < 16896 / 4; e += 512) ((LAS unsigned*)(lds + ST))[e] = 0u;
        f32x4 sacc[2][2];
#pragma unroll
        for (int i = 0; i < 2; ++i)
#pragma unroll
            for (int j = 0; j < 2; ++j) sacc[i][j] = (f32x4){0.f, 0.f, 0.f, 0.f};
        v4u rq0[4], rk0[4], ra0, rq1[4], rk1[4], ra1; v2u rv0, rv1; f32x4 rav0 = {0.f, 0.f, 0.f, 0.f}, rav1 = rav0;
#define GLA_LOAD(cc, S) do { \
        _Pragma("unroll") for (int r = 0; r < 4; ++r) { const int e = tid + 512 * r; rq##S[r] = *(const v4u*)(qbase + (size_t)((cc) * 64 + (e >> 5)) * 1024 + (e & 31) * 8); } \
        _Pragma("unroll") for (int r = 0; r < 4; ++r) rk##S[r] = *(const v4u*)(ktbase + (size_t)(cc) * 16384 + (size_t)(tid + 512 * r) * 8); \
        ra##S = *(const v4u*)(abase + (size_t)(cc) * 4096 + tid * 8); \
        rv##S = *(const v2u*)(vbase + (size_t)((cc) * 64 + (tid >> 3)) * 2048 + (tid & 7) * 4); \
        rav##S = *(const f32x4*)(avbase + (cc) * 256 + (tid & 63) * 4); } while (0)
#define GLA_STEP(c, S) do { \
            _Pragma("unroll") for (int r = 0; r < 4; ++r) { const int e = tid + 512 * r; *(LAS v4u*)(lds + QS + (e >> 5) * 528 + (e & 31) * 16) = rq##S[r]; *(LAS v4u*)(lds + KT + (e >> 3) * 144 + (e & 7) * 16) = rk##S[r]; } \
            *(LAS v4u*)(lds + AS + (tid >> 3) * 144 + (tid & 7) * 16) = ra##S; \
            { LAS unsigned short* vt = (LAS unsigned short*)(lds + VT); const int j = tid >> 3, n0 = 4 * (tid & 7); \
              vt[(n0 + 0) * 72 + j] = (unsigned short)(rv##S.x & 0xffffu); vt[(n0 + 1) * 72 + j] = (unsigned short)(rv##S.x >> 16); \
              vt[(n0 + 2) * 72 + j] = (unsigned short)(rv##S.y & 0xffffu); vt[(n0 + 3) * 72 + j] = (unsigned short)(rv##S.y >> 16); } \
            if (tid < 64) *(LAS f32x4*)(lds + AV + tid * 16) = rav##S; \
            BAR_LDS(); \
            GLA_LOAD(((c) + 2 < NCH ? (c) + 2 : NCH - 1), S); \
            { const int nt = wave & 1, itl = wave >> 1; \
              f32x4 oa = {0.f, 0.f, 0.f, 0.f}, ob = oa; \
              _Pragma("unroll") for (int kk = 0; kk < 8; kk += 2) { \
                  const bf16x8 a0 = *(const LAS bf16x8*)(lds + ST + (16 * nt + l15) * 528 + (32 * kk + 8 * g4) * 2), b0 = *(const LAS bf16x8*)(lds + QS + (16 * itl + l15) * 528 + (32 * kk + 8 * g4) * 2); \
                  const bf16x8 a1 = *(const LAS bf16x8*)(lds + ST + (16 * nt + l15) * 528 + (32 * kk + 32 + 8 * g4) * 2), b1 = *(const LAS bf16x8*)(lds + QS + (16 * itl + l15) * 528 + (32 * kk + 32 + 8 * g4) * 2); \
                  oa = __builtin_amdgcn_mfma_f32_16x16x32_bf16(a0, b0, oa, 0, 0, 0); ob = __builtin_amdgcn_mfma_f32_16x16x32_bf16(a1, b1, ob, 0, 0, 0); } \
              { const bf16x8 a0 = *(const LAS bf16x8*)(lds + VT + (16 * nt + l15) * 144 + (8 * g4) * 2), b0 = *(const LAS bf16x8*)(lds + AS + (16 * itl + l15) * 144 + (8 * g4) * 2); \
                const bf16x8 a1 = *(const LAS bf16x8*)(lds + VT + (16 * nt + l15) * 144 + (32 + 8 * g4) * 2), b1 = *(const LAS bf16x8*)(lds + AS + (16 * itl + l15) * 144 + (32 + 8 * g4) * 2); \
                oa = __builtin_amdgcn_mfma_f32_16x16x32_bf16(a0, b0, oa, 0, 0, 0); ob = __builtin_amdgcn_mfma_f32_16x16x32_bf16(a1, b1, ob, 0, 0, 0); } \
              oa = oa + ob; \
              v2u w; w.x = pk_c(oa[0], oa[1]); w.y = pk_c(oa[2], oa[3]); \
              *(v2u*)(obase + (size_t)((c) * 64 + 16 * itl + l15) * 2048 + 16 * nt + 4 * g4) = w; } \
            asm volatile("" ::: "memory"); \
            _Pragma("unroll") for (int kt = 0; kt < 2; ++kt) { \
                const f32x4 dec = *(const LAS f32x4*)(lds + AV + (32 * wave + 16 * kt + 4 * g4) * 4); \
                const bf16x8 ka0 = *(const LAS bf16x8*)(lds + KT + (32 * wave + 16 * kt + l15) * 144 + (8 * g4) * 2), ka1 = *(const LAS bf16x8*)(lds + KT + (32 * wave + 16 * kt + l15) * 144 + (32 + 8 * g4) * 2); \
                _Pragma("unroll") for (int nt = 0; nt < 2; ++nt) { \
                    const bf16x8 vb0 = *(const LAS bf16x8*)(lds + VT + (16 * nt + l15) * 144 + (8 * g4) * 2), vb1 = *(const LAS bf16x8*)(lds + VT + (16 * nt + l15) * 144 + (32 + 8 * g4) * 2); \
                    f32x4 sv = sacc[kt][nt] * dec; \
                    sv = __builtin_amdgcn_mfma_f32_16x16x32_bf16(ka0, vb0, sv, 0, 0, 0); sv = __builtin_amdgcn_mfma_f32_16x16x32_bf16(ka1, vb1, sv, 0, 0, 0); \
                    sacc[kt][nt] = sv; } } \
            BAR_LDS(); \
            _Pragma("unroll") for (int kt = 0; kt < 2; ++kt) \
                _Pragma("unroll") for (int nt = 0; nt < 2; ++nt) { const f32x4 sv = sacc[kt][nt]; v2u w; w.x = pk_c(sv[0], sv[1]); w.y = pk_c(sv[2], sv[3]); \
                    *(LAS v2u*)(lds + ST + (16 * nt + l15) * 528 + (32 * wave + 16 * kt + 4 * g4) * 2) = w; } \
        } while (0)
        GLA_LOAD(0, 0); GLA_LOAD(1, 1);
        for (int c = 0; c < NCH; c += 2) { GLA_STEP(c, 0); GLA_STEP(c + 1, 1); }
#undef GLA_LOAD
#undef GLA_STEP
        __syncthreads();
    }
}

__device__ __forceinline__ void on_pass(const Args& a, int lane, int wave, int G) {
    const bf16* O = (const bf16*)((unsigned char*)a.out + DO_O); bf16* ON = (bf16*)(a.ws + Z_V); const bf16* R = (const bf16*)(a.ws + Z_R);
    const f32x4 gA = *(const f32x4*)(a.in[7] + 8 * lane), gB = *(const f32x4*)(a.in[7] + 8 * lane + 4);
    const int gw = blockIdx.x * 8 + wave, NGW = G * 8;
    for (int row = gw; row < M; row += NGW) {
        const bf16* o = O + (size_t)row * 2048 + 8 * lane; bf16* on = ON + (size_t)row * 2048 + 8 * lane; const bf16* r = R + (size_t)row * 2048 + 8 * lane;
        v4u ov[4], rv[4];
#pragma unroll
        for (int j = 0; j < 4; ++j) { ov[j] = *(const v4u*)(o + 512 * j); rv[j] = *(const v4u*)(r + 512 * j); }
#pragma unroll
        for (int j = 0; j < 4; ++j) { float f[8], s[8]; unpack8(ov[j], f); unpack8(rv[j], s); float ss = 0.f;
#pragma unroll
            for (int i = 0; i < 8; ++i) ss += f[i] * f[i];
            const float rs = rsqrtf(wave_sum(ss) * (1.f / 512.f) + EPS);
#pragma unroll
            for (int i = 0; i < 4; ++i) { f[i] = f[i] * rs * gA[i] * s[i]; f[4 + i] = f[4 + i] * rs * gB[i] * s[4 + i]; }
            *(v4u*)(on + 512 * j) = pack8(f); }
    }
}
template <int MODE> __device__ __forceinline__ void res_pass(const float* xin, const bf16* U, const float* g1p, const float* g2p, float* out, bf16* H2, int lane, int wave, int G) {
    f32x4 g1[4][2], g2[4][2];
#pragma unroll
    for (int j = 0; j < 4; ++j)
#pragma unroll
        for (int q = 0; q < 2; ++q) { g1[j][q] = *(const f32x4*)(g1p + 512 * j + 8 * lane + 4 * q); if (MODE == 0) g2[j][q] = *(const f32x4*)(g2p + 512 * j + 8 * lane + 4 * q); }
    const int gw = blockIdx.x * 8 + wave, NGW = G * 8;
    for (int row = gw; row < M; row += NGW) {
        const size_t ro = (size_t)row * 2048 + 8 * lane;
        v4u uv[4]; f32x4 xv[4][2];
#pragma unroll
        for (int j = 0; j < 4; ++j) { uv[j] = *(const v4u*)(U + ro + 512 * j); xv[j][0] = *(const f32x4*)(xin + ro + 512 * j); xv[j][1] = *(const f32x4*)(xin + ro + 512 * j + 4); }
        float uf[4][8]; float ss = 0.f;
#pragma unroll
        for (int j = 0; j < 4; ++j) { unpack8(uv[j], uf[j]);
#pragma unroll
            for (int i = 0; i < 8; ++i) ss += uf[j][i] * uf[j][i]; }
        const float rs = rsqrtf(wave_sum(ss) * (1.f / 2048.f) + EPS);
        float s1 = 0.f;
#pragma unroll
        for (int j = 0; j < 4; ++j)
#pragma unroll
            for (int q = 0; q < 2; ++q)
#pragma unroll
                for (int i = 0; i < 4; ++i) { const float v = xv[j][q][i] + uf[j][4 * q + i] * rs * g1[j][q][i]; xv[j][q][i] = v; s1 += v * v; }
#pragma unroll
        for (int j = 0; j < 4; ++j) { *(f32x4*)(out + ro + 512 * j) = xv[j][0]; *(f32x4*)(out + ro + 512 * j + 4) = xv[j][1]; }
        if (MODE == 0) {
            const float r1 = rsqrtf(wave_sum(s1) * (1.f / 2048.f) + EPS);
#pragma unroll
            for (int j = 0; j < 4; ++j) { float f[8];
#pragma unroll
                for (int i = 0; i < 4; ++i) { f[i] = xv[j][0][i] * r1 * g2[j][0][i]; f[4 + i] = xv[j][1][i] * r1 * g2[j][1][i]; }
                *(v4u*)(H2 + ro + 512 * j) = pack8(f); }
        }
    }
}

#ifndef PH_MASK
#define PH_MASK 0xffff
#endif
#define PH(n) ((PH_MASK >> (n)) & 1)
#ifndef DBL_MASK
#define DBL_MASK 0x0
#endif
#define REP(k) (((DBL_MASK >> (k)) & 1) ? 2 : 1)
#define RUN(k, ...) for (int rep_ = 0; rep_ < REP(k); ++rep_) { if (rep_) { __syncthreads(); grid.sync(); } __VA_ARGS__ }
typedef const __attribute__((address_space(4))) Args* ArgsP;
__device__ __forceinline__ ArgsP get_args() { ArgsP p = (ArgsP)__builtin_amdgcn_kernarg_segment_ptr(); asm volatile("" : "+s"(p)); return p; }
__global__ void __launch_bounds__(512, 2) fwd_kernel(Args a_unused) {
    extern __shared__ __attribute__((aligned(16))) unsigned char lds_raw[];
    LAS unsigned char* lds = (LAS unsigned char*)lds_raw;
    cg::grid_group grid = cg::this_grid();
    const int wave_s = __builtin_amdgcn_readfirstlane(threadIdx.x >> 6); int tid, lane, wave; const int G = gridDim.x;
#define LAUNDER() do { unsigned m_ = ~0u; int w_ = wave_s; asm volatile("" : "+s"(m_), "+s"(w_)); lane = (int)__builtin_amdgcn_mbcnt_hi(m_, __builtin_amdgcn_mbcnt_lo(m_, 0u)); wave = w_; tid = (wave << 6) | lane; } while (0)
    { ArgsP ap0 = get_args(); unsigned* ctl = (unsigned*)(ap0->ws + WS_CTL);
      if (threadIdx.x == 0) { const unsigned xcc = (unsigned)__builtin_amdgcn_s_getreg((3 << 11) | 20) & 0xFu; const unsigned rank = atomicAdd(ctl + 64 * (xcc & 7u), 1u);
          volatile LAS unsigned* lc = (volatile LAS unsigned*)(lds + LDS_CTL); lc[0] = xcc; lc[1] = rank; lc[2] = blockIdx.x; } }
#define PHASE_ARGS() ArgsP ap_ = get_args(); Args a; _Pragma("unroll") for (int i_ = 0; i_ < 18; ++i_) a.in[i_] = ap_->in[i_]; a.out = ap_->out; a.ws = ap_->ws; unsigned char* const ws = a.ws; (void)ws; const int vc = __builtin_amdgcn_readfirstlane((int)((volatile LAS unsigned*)(lds + LDS_CTL))[2]); (void)vc
    typedef pg8::StaticOrder SO;
#if PH(0)
    LAUNDER();
    { PHASE_ARGS();
    RUN(0, phase0(a, lds, tid, lane, wave, G); )
    }
#endif
    grid.sync();
    { ArgsP ap0 = get_args(); unsigned* ctl = (unsigned*)(ap0->ws + WS_CTL);
      if (threadIdx.x == 0) { volatile LAS unsigned* lc = (volatile LAS unsigned*)(lds + LDS_CTL); bool ok = (G % 8) == 0;
          for (int x = 0; x < 8; ++x) ok = ok && (__hip_atomic_load(ctl + 64 * x, __ATOMIC_RELAXED, __HIP_MEMORY_SCOPE_AGENT) == (unsigned)(G / 8));
          const unsigned xcc = lc[0], rank = lc[1]; lc[2] = (ok && xcc < 8u) ? xcc + 8u * rank : blockIdx.x; }
      __syncthreads(); }
#if PH(1)
    LAUNDER();
    { PHASE_ARGS();
    RUN(1, { pg8::Gemm g{(const bf16*)(ws + WS_XN), (const bf16*)(ws + WS_WIN), D, D, D, 0}; SO S; S.init(M, NZ, G, vc);
      Epi<E_Z> E{}; E.vec = a.in[10]; E.zP = (bf16*)(ws + Z_P); E.zQ = (bf16*)(ws + Z_Q); E.zK = (bf16*)(ws + Z_K); E.zV = (bf16*)(ws + Z_V); E.zR = (bf16*)(ws + Z_R); E.zG = (bf16*)(ws + Z_G);
      pg8::gemm_phase<Epi<E_Z>, SO, true, true>(lds, g, S, E, tid); } )
    }
#endif
    grid.sync();
#if PH(2)
    LAUNDER();
    { PHASE_ARGS();
    RUN(2, pool_diff((const bf16*)(ws + Z_P), (bf16*)((unsigned char*)a.out + DO_DIFF), lane, wave, G); )
    RUN(3, gla_prepass(a, lds, tid, lane, wave, G); )
    }
#endif
    grid.sync();
#if PH(3)
    LAUNDER();
    { PHASE_ARGS();
    RUN(4, gla_seq(a, lds, tid, lane, wave, G, vc); )
    RUN(5, { pg8::Gemm g{(const bf16*)((unsigned char*)a.out + DO_DIFF), (const bf16*)(ws + WS_WP), PW, 256, 256, 512}; SO S; S.init(M, PW, G, vc);
      Epi<E_POOL> E{}; E.O = (bf16*)(ws + Z_P); E.ldc = PW; E.vec = a.in[6];
      pg8::gemm_phase<Epi<E_POOL>, SO, true, true>(lds, g, S, E, tid); } )
    }
#endif
    grid.sync();
#if PH(4)
    LAUNDER();
    { PHASE_ARGS();
    RUN(6, on_pass(a, lane, wave, G); )
    RUN(7, { pg8::Gemm g{(const bf16*)(ws + Z_P), (const bf16*)(ws + WS_WA), PW, PW, PW, 0}; SO S; S.init(M, D, G, vc);
      Epi<E_YA> E{}; E.O = (bf16*)(ws + WS_T); E.ldc = D; E.Gt = (const bf16*)(ws + Z_G);
      pg8::gemm_phase<Epi<E_YA>, SO, true, true>(lds, g, S, E, tid); } )
    }
#endif
    grid.sync();
#if PH(5)
    LAUNDER();
    { PHASE_ARGS();
    RUN(8, { pg8::Gemm g{(const bf16*)(ws + Z_V), (const bf16*)(ws + WS_WB), D, D, D, 0}; SO S; S.init(M, D, G, vc);
      Epi<E_YB> E{}; E.O = (bf16*)(ws + WS_MIX); E.Tin = (const bf16*)(ws + WS_T); E.ldc = D; E.Gt = (const bf16*)(ws + Z_G) + 2048;
      pg8::gemm_phase<Epi<E_YB>, SO, true, true>(lds, g, S, E, tid); } )
    }
#endif
    grid.sync();
#if PH(6)
    LAUNDER();
    { PHASE_ARGS();
    RUN(9, { pg8::Gemm g{(const bf16*)(ws + WS_MIX), (const bf16*)(ws + WS_WOUT), D, D, D, 0}; SO S; S.init(M, D, G, vc);
      Epi<E_PLAIN> E{}; E.O = (bf16*)(ws + WS_U); E.ldc = D;
      pg8::gemm_phase<Epi<E_PLAIN>, SO, true, true>(lds, g, S, E, tid); } )
    }
#endif
    grid.sync();
#if PH(7)
    LAUNDER();
    { PHASE_ARGS();
    RUN(10, res_pass<0>(a.in[0], (const bf16*)(ws + WS_U), a.in[12], a.in[13], a.out, (bf16*)(ws + WS_H2), lane, wave, G); )
    }
#endif
    grid.sync();
#if PH(8)
    LAUNDER();
    { PHASE_ARGS();
    RUN(11, { pg8::Gemm g{(const bf16*)(ws + WS_H2), (const bf16*)(ws + WS_WGU), D, D, D, 0}; SO S; S.init(M, NGU, G, vc);
      Epi<E_SWIGLU> E{}; E.O = (bf16*)(ws + WS_F); E.ldc = FF;
      pg8::gemm_phase<Epi<E_SWIGLU>, SO, true, true>(lds, g, S, E, tid); } )
    }
#endif
    grid.sync();
#if PH(9)
    LAUNDER();
    { PHASE_ARGS();
    RUN(12, { pg8::Gemm g{(const bf16*)(ws + WS_F), (const bf16*)(ws + WS_WD), FF, FF, FF, 0}; SO S; S.init(M, D, G, vc);
      Epi<E_PLAIN> E{}; E.O = (bf16*)(ws + WS_FO); E.ldc = D;
      pg8::gemm_phase<Epi<E_PLAIN>, SO, true, true>(lds, g, S, E, tid); } )
    }
#endif
    grid.sync();
#if PH(10)
    LAUNDER();
    { PHASE_ARGS();
    res_pass<1>(a.out, (const bf16*)(ws + WS_FO), a.in[17], nullptr, a.out, nullptr, lane, wave, G);
    }
#endif
}

extern "C" void kernel_launch(void* const* d_in, const int* in_sizes, int n_in, void* d_out, int out_size, void* d_ws, size_t ws_size, hipStream_t stream) {
    static int grid = 0;
    if (grid == 0) {
        if (n_in != 18 || in_sizes[0] != M * D || out_size != M * D || ws_size < WS_NEED) {
            fprintf(stderr, "kernel_launch: unexpected shapes (n_in %d in0 %d out %d ws %zu need %zu)\n", n_in, n_in > 0 ? in_sizes[0] : -1, out_size, ws_size, (size_t)WS_END); grid = -1; return; }
        int dev = 0, cus = 0, per_cu = 0;
        hipGetDevice(&dev); hipDeviceGetAttribute(&cus, hipDeviceAttributeMultiprocessorCount, dev);
        hipFuncSetAttribute((const void*)fwd_kernel, hipFuncAttributeMaxDynamicSharedMemorySize, LDS_BYTES);
        if (hipOccupancyMaxActiveBlocksPerMultiprocessor(&per_cu, (const void*)fwd_kernel, 512, LDS_BYTES) != hipSuccess || per_cu < 1) per_cu = 1;
        (void)hipGetLastError();
        grid = cus * per_cu;
    }
    if (grid < 0) return;
    (void)hipMemsetAsync((unsigned char*)d_ws + WS_CTL, 0, CTL_BYTES, stream);
    Args a{};
    for (int i = 0; i < 18; ++i) a.in[i] = (const float*)d_in[i];
    a.out = (float*)d_out; a.ws = (unsigned char*)d_ws;
    void* args[] = {&a};
    hipError_t e = hipLaunchCooperativeKernel((const void*)fwd_kernel, dim3(grid), dim3(512), args, LDS_BYTES, stream);
    if (e != hipSuccess) fprintf(stderr, "cooperative launch failed: %s (grid %d)\n", hipGetErrorString(e), grid);
}
```

```cpp
#include <hip/hip_runtime.h>
#include <hip/hip_cooperative_groups.h>
#include <cstdio>
#include <cstdint>
namespace cg = cooperative_groups;

namespace pg8 {
#define PG8_LAS __attribute__((address_space(3)))
typedef unsigned short bf16_t;
typedef short bf16x8 __attribute__((ext_vector_type(8)));
typedef float f32x4 __attribute__((ext_vector_type(4)));
typedef unsigned u32x4 __attribute__((ext_vector_type(4)));
constexpr int BM = 256, BK = 64, HALF = 128, HTB = HALF * BK * 2  , STAGE_BYTES = 8 * HTB, NXCD = 8, WGM = 8;

__host__ __device__ __forceinline__ int lds_byte(int r, int c) { const int st = (r >> 4) * 2 + (c >> 5), rr = r & 15, cc = c & 31, ob = rr * 64 + cc * 2; return st * 1024 + (ob ^ (((ob >> 9) & 1) << 5)); }
__host__ __device__ __forceinline__ void stage_rc(int b, int& R, int& C) { const int st = b / 1024, sb = b % 1024, swz = sb ^ (((sb >> 9) & 1) << 5); R = (st >> 1) * 16 + swz / 64; C = (st & 1) * 32 + (swz % 64) / 2; }
__host__ __device__ __forceinline__ int perm32(int rho) { const int n = rho >> 4, i = rho & 15; return 8 * (i >> 2) + 4 * n + (i & 3); }

struct Unit { int pm, pn; };
struct Gemm { const bf16_t* A; const bf16_t* Bt; int lda, ldb, K; size_t apn; };
struct StaticOrder {
    int nM, nN, nwg, G, c;
    __host__ __device__ void init(int M, int N, int G_, int c_) { nM = M / BM; nN = N / BM; nwg = nM * nN; G = G_; c = c_; }
    __host__ __device__ bool next(int i, Unit& u) const {
        const long L = (long)i * G + c; if (L >= nwg) return false;
        int wgid = (int)L; { const int q = nwg / NXCD, r = nwg % NXCD, xcd = wgid % NXCD, off = wgid / NXCD; wgid = (xcd < r ? xcd * (q + 1) : r * (q + 1) + (xcd - r) * q) + off; }
        const int nig = WGM * nN, gid = wgid / nig, fm = gid * WGM, gsz = (nM - fm) < WGM ? (nM - fm) : WGM;
        u.pm = fm + ((wgid % nig) % gsz); u.pn = (wgid % nig) / gsz; return true;
    }
    __device__ __forceinline__ void a_ready(const Unit&) const {}
    __device__ __forceinline__ void done(const Unit&) const {}
};
__device__ __forceinline__ unsigned cvt_pk_bf16(float lo, float hi) { unsigned r; asm volatile("v_cvt_pk_bf16_f32 %0, %1, %2" : "=v"(r) : "v"(lo), "v"(hi)); return r; }
template <class Epi, class Sched, bool ALIGN_EPI = false, bool SP2 = false>
__device__ __forceinline__ void gemm_phase(PG8_LAS unsigned char* lds, const Gemm g, const Sched& S, const Epi& E, const int tid_in) {
    const int tid = tid_in, wid = __builtin_amdgcn_readfirstlane(tid >> 6), lane = tid & 63, wr = wid >> 2, wc = wid & 3, fr = lane & 15, fq = lane >> 4;
    const int K = g.K, nt = K / BK;
    unsigned voffA[2], voffB[2];
#pragma unroll
    for (int i = 0; i < 2; ++i) { int R, C; stage_rc(tid * 16 + i * 8192, R, C); const int Rb = Epi::PERM ? ((R & ~31) + perm32(R & 31)) : R;
        voffA[i] = (unsigned)(R * g.lda + C) * 2u; voffB[i] = (unsigned)(Rb * g.ldb + C) * 2u; }
    const size_t kstep = (size_t)(BK * 2);
    const size_t hstepA = (size_t)HALF * g.lda * 2, hstepB = (size_t)HALF * g.ldb * 2;
    const size_t tstepA = 2 * hstepA, tstepB = 2 * hstepB;
    const unsigned ldsw = (unsigned)wid * 1024u;
    const int aoff = lds_byte(wr * 64 + fr, fq * 8), boff = lds_byte(wc * 32 + fr, fq * 8);
#define PG8_SA(b, h) (((b) * 2 + (h)) * HTB)
#define PG8_SB(b, h) ((4 + (b) * 2 + (h)) * HTB)
#define PG8_STAGE(bufoff, gbase, voff) do { _Pragma("unroll") for (int _i = 0; _i < 2; ++_i) \
        __builtin_amdgcn_global_load_lds((const unsigned*)((const char*)(gbase) + (voff)[_i]), (PG8_LAS unsigned*)(lds + (bufoff) + ldsw + _i * 8192), 16, 0, 0); } while (0)
#define PG8_LDA(dst, b, h) do { _Pragma("unroll") for (int m = 0; m < 4; ++m) _Pragma("unroll") for (int k = 0; k < 2; ++k) dst[m][k] = *(const PG8_LAS bf16x8*)(lds + PG8_SA(b, h) + aoff + m * 2048 + k * 1024); } while (0)
#define PG8_LDB(dst, b, h) do { _Pragma("unroll") for (int n = 0; n < 2; ++n) _Pragma("unroll") for (int k = 0; k < 2; ++k) dst[n][k] = *(const PG8_LAS bf16x8*)(lds + PG8_SB(b, h) + boff + n * 2048 + k * 1024); } while (0)
#define PG8_MMA(ai, bj, At, Bt) do { __builtin_amdgcn_s_setprio(1); _Pragma("unroll") for (int m = 0; m < 4; ++m) _Pragma("unroll") for (int n = 0; n < 2; ++n) _Pragma("unroll") for (int k = 0; k < 2; ++k) \
        acc[ai][bj][m][n] = __builtin_amdgcn_mfma_f32_16x16x32_bf16(Bt[n][k], At[m][k], acc[ai][bj][m][n], 0, 0, 0); __builtin_amdgcn_s_setprio(0); } while (0)
#define PG8_WAIT_V(n) asm volatile("s_waitcnt vmcnt(" #n ")" ::: "memory")
#define PG8_WAIT_L(n) asm volatile("s_waitcnt lgkmcnt(" #n ")" ::: "memory")
#define PG8_BAR __builtin_amdgcn_s_barrier()
#define PG8_SCHED __builtin_amdgcn_sched_barrier(0)
    Unit cur, nxt; int ui = 0;
    if (!S.next(0, cur)) return;
    f32x4 acc[2][2][4][2];
#pragma unroll
    for (int a = 0; a < 2; ++a)
#pragma unroll
        for (int b = 0; b < 2; ++b)
#pragma unroll
            for (int m = 0; m < 4; ++m)
#pragma unroll
                for (int n = 0; n < 2; ++n) acc[a][b][m][n] = (f32x4){0.f, 0.f, 0.f, 0.f};
    bf16x8 At[4][2], B0[2][2], B1[2][2];
    const char* cA = (const char*)g.A + (size_t)cur.pm * tstepA + (size_t)cur.pn * g.apn; const char* cB = (const char*)g.Bt + (size_t)cur.pn * tstepB;
    S.a_ready(cur);
    if constexpr (SP2) {
        PG8_STAGE(PG8_SB(0, 0), cB, voffB); PG8_STAGE(PG8_SB(0, 1), cB + hstepB, voffB); PG8_STAGE(PG8_SA(0, 0), cA, voffA); PG8_STAGE(PG8_SA(0, 1), cA + hstepA, voffA);
        if (wr == 1) PG8_BAR;
        PG8_WAIT_V(2); PG8_BAR;
        PG8_STAGE(PG8_SB(1, 0), cB + kstep, voffB); PG8_STAGE(PG8_SA(1, 0), cA + kstep, voffA); PG8_STAGE(PG8_SB(1, 1), cB + hstepB + kstep, voffB);
        PG8_WAIT_V(6); PG8_BAR;
    } else {
        PG8_STAGE(PG8_SB(0, 0), cB, voffB); PG8_STAGE(PG8_SA(0, 0), cA, voffA); PG8_STAGE(PG8_SB(0, 1), cB + hstepB, voffB); PG8_STAGE(PG8_SA(0, 1), cA + hstepA, voffA);
        if (wr == 1) PG8_BAR;
        PG8_WAIT_V(4); PG8_BAR;
        PG8_STAGE(PG8_SB(1, 0), cB + kstep, voffB); PG8_STAGE(PG8_SA(1, 0), cA + kstep, voffA); PG8_STAGE(PG8_SB(1, 1), cB + hstepB + kstep, voffB);
        PG8_WAIT_V(6); PG8_BAR;
    }
    for (;;) {
        const bool has_next = S.next(ui + 1, nxt);
        const char* nA = has_next ? (const char*)g.A + (size_t)nxt.pm * tstepA + (size_t)nxt.pn * g.apn : cA; const char* nB = has_next ? (const char*)g.Bt + (size_t)nxt.pn * tstepB : cB;
        for (int t = 0; t < nt; t += 2) {
            const bool last = (t == nt - 2);
            const char* a1 = cA + (size_t)(t + 1) * kstep;
            const char* a2 = last ? nA : cA + (size_t)(t + 2) * kstep; const char* b2 = last ? nB : cB + (size_t)(t + 2) * kstep;
            const char* a3 = a2 + kstep; const char* b3 = b2 + kstep;
            if (last && has_next) S.a_ready(nxt);
            if constexpr (SP2) {
            PG8_LDB(B0, 0, 0); PG8_LDB(B1, 0, 1); PG8_SCHED; PG8_LDA(At, 0, 0); PG8_STAGE(PG8_SA(1, 1), a1 + hstepA, voffA);
            PG8_WAIT_V(8); PG8_WAIT_L(0); PG8_BAR; PG8_MMA(0, 0, At, B0); PG8_MMA(0, 1, At, B1); PG8_BAR; PG8_SCHED;
            PG8_LDA(At, 0, 1); PG8_STAGE(PG8_SB(0, 0), b2, voffB); PG8_STAGE(PG8_SB(0, 1), b2 + hstepB, voffB); PG8_STAGE(PG8_SA(0, 0), a2, voffA);
            PG8_WAIT_V(8); PG8_WAIT_L(0); PG8_BAR; PG8_MMA(1, 0, At, B0); PG8_MMA(1, 1, At, B1); PG8_BAR; PG8_SCHED;
            PG8_LDB(B0, 1, 0); PG8_LDB(B1, 1, 1); PG8_SCHED; PG8_LDA(At, 1, 0); PG8_STAGE(PG8_SA(0, 1), a2 + hstepA, voffA);
            PG8_WAIT_V(8); PG8_WAIT_L(0); PG8_BAR; PG8_MMA(0, 0, At, B0); PG8_MMA(0, 1, At, B1); PG8_BAR; PG8_SCHED;
            PG8_LDA(At, 1, 1); PG8_STAGE(PG8_SB(1, 0), b3, voffB); PG8_STAGE(PG8_SB(1, 1), b3 + hstepB, voffB); PG8_STAGE(PG8_SA(1, 0), a3, voffA);
            PG8_WAIT_V(8); PG8_WAIT_L(0); PG8_BAR; PG8_MMA(1, 0, At, B0); PG8_MMA(1, 1, At, B1); PG8_BAR; PG8_SCHED;
            } else {
            PG8_LDB(B0, 0, 0); PG8_SCHED; PG8_LDA(At, 0, 0); PG8_STAGE(PG8_SA(1, 1), a1 + hstepA, voffA);
            PG8_WAIT_L(8); PG8_BAR; PG8_WAIT_L(0); PG8_MMA(0, 0, At, B0); PG8_BAR; PG8_SCHED;
            PG8_LDB(B1, 0, 1); PG8_STAGE(PG8_SB(0, 0), b2, voffB);
            PG8_BAR; PG8_WAIT_L(0); PG8_MMA(0, 1, At, B1); PG8_BAR;
            PG8_LDA(At, 0, 1); PG8_STAGE(PG8_SA(0, 0), a2, voffA);
            PG8_BAR; PG8_WAIT_L(0); PG8_MMA(1, 0, At, B0); PG8_BAR; PG8_SCHED;
            PG8_STAGE(PG8_SB(0, 1), b2 + hstepB, voffB);
            PG8_WAIT_V(6); PG8_BAR; PG8_MMA(1, 1, At, B1); PG8_BAR;
            PG8_LDB(B0, 1, 0); PG8_SCHED; PG8_LDA(At, 1, 0); PG8_STAGE(PG8_SA(0, 1), a2 + hstepA, voffA);
            PG8_WAIT_L(8); PG8_BAR; PG8_WAIT_L(0); PG8_MMA(0, 0, At, B0); PG8_BAR; PG8_SCHED;
            PG8_LDB(B1, 1, 1); PG8_STAGE(PG8_SB(1, 0), b3, voffB);
            PG8_BAR; PG8_WAIT_L(0); PG8_MMA(0, 1, At, B1); PG8_BAR;
            PG8_LDA(At, 1, 1); PG8_STAGE(PG8_SA(1, 0), a3, voffA);
            PG8_BAR; PG8_WAIT_L(0); PG8_MMA(1, 0, At, B0); PG8_BAR; PG8_SCHED;
            PG8_STAGE(PG8_SB(1, 1), b3 + hstepB, voffB);
            PG8_WAIT_V(6); PG8_BAR; PG8_MMA(1, 1, At, B1); PG8_BAR;
            }
        }
        if constexpr (ALIGN_EPI) { if (wr == 0) PG8_BAR; }
        if constexpr (!Epi::AFTER_DRAIN) { E(acc, cur, wr, wc, fr, fq); S.done(cur); }
        if (!has_next) break;
#pragma unroll
        for (int a = 0; a < 2; ++a)
#pragma unroll
            for (int b = 0; b < 2; ++b)
#pragma unroll
                for (int m = 0; m < 4; ++m)
#pragma unroll
                    for (int n = 0; n < 2; ++n) acc[a][b][m][n] = (f32x4){0.f, 0.f, 0.f, 0.f};
        cur = nxt; cA = nA; cB = nB; ++ui;
        if constexpr (ALIGN_EPI) { if (wr == 1) PG8_BAR; }
    }
    PG8_WAIT_V(0);
    if constexpr (!ALIGN_EPI) { if (wr == 0) PG8_BAR; }
    PG8_BAR;
    if constexpr (Epi::AFTER_DRAIN) { E.fused(acc, cur, wr, wc, fr, fq, lds, wid, lane); S.done(cur); }
#undef PG8_SA
#undef PG8_SB
#undef PG8_STAGE
#undef PG8_LDA
#undef PG8_LDB
#undef PG8_MMA
#undef PG8_WAIT_V
#undef PG8_WAIT_L
#undef PG8_BAR
#undef PG8_SCHED
}
}


#define LAS __attribute__((address_space(3)))
typedef unsigned short bf16;
typedef unsigned v4u __attribute__((ext_vector_type(4)));
typedef unsigned v2u __attribute__((ext_vector_type(2)));
using pg8::f32x4; using pg8::bf16x8; using pg8::Unit;
#define LDS_WAIT() asm volatile("s_waitcnt lgkmcnt(0)" ::: "memory")
#define BAR_LDS() do { asm volatile("s_waitcnt lgkmcnt(0)" ::: "memory"); __builtin_amdgcn_s_barrier(); asm volatile("" ::: "memory"); } while (0)

constexpr int NB = 4, T = 8192, D = 2048, M = NB * T;
constexpr int PW = 1024, KD = 1024, VD = 2048, HK = 256, HV = 512, FF = 5632, DIN = 11280, NZ = 11264, NGU = 11264, NCH = 128;
constexpr float EPS = 1e-6f;
constexpr int LDS_BYTES = 147456;
constexpr size_t MiB = 1u << 20;
constexpr size_t WS_WIN = 0, WS_WGU = 44 * MiB, WS_WD = 88 * MiB, WS_WB = 110 * MiB, WS_WOUT = 118 * MiB, WS_WA = 126 * MiB, WS_WP = 130 * MiB,
                 WS_GLR = 131 * MiB, WS_XN = 133 * MiB, WS_Z = 261 * MiB;
constexpr size_t Z_P = WS_Z, Z_Q = Z_P + 64 * MiB, Z_K = Z_Q + 64 * MiB, Z_V = Z_K + 64 * MiB, Z_R = Z_V + 128 * MiB, Z_G = Z_R + 128 * MiB, WS_END = Z_G + 256 * MiB;
constexpr size_t WS_CTL = WS_END, CTL_BYTES = 32768, CTL_BAR_OFF = 4096, WS_NEED = WS_END + CTL_BYTES;
constexpr int LDS_CTL = 131072 + 1024;
constexpr size_t WS_KDT = WS_XN, WS_QP = WS_XN + 64 * MiB, WS_T = WS_XN, WS_MIX = Z_Q, WS_U = WS_XN, WS_H2 = Z_G, WS_F = WS_Z, WS_FO = WS_Z + 352 * MiB;
constexpr size_t DO_DIFF = 0, DO_AMAT = 64 * MiB, DO_AVEC = 80 * MiB, DO_O = 96 * MiB;

struct Args { const float* in[18]; float* out; unsigned char* ws; };

__device__ __forceinline__ float bflo(unsigned u) { return __uint_as_float(u << 16); }
__device__ __forceinline__ float bfhi(unsigned u) { return __uint_as_float(u & 0xffff0000u); }
typedef float f32x2_t __attribute__((ext_vector_type(2)));
typedef __bf16 bf16x2_t __attribute__((ext_vector_type(2)));
__device__ __forceinline__ unsigned pk_c(float lo, float hi) { f32x2_t v = {lo, hi}; bf16x2_t b = __builtin_convertvector(v, bf16x2_t); return __builtin_bit_cast(unsigned, b); }
__device__ __forceinline__ unsigned pk(float lo, float hi) { return pg8::cvt_pk_bf16(lo, hi); }
__device__ __forceinline__ float sigm(float x) { return 1.f / (1.f + __expf(-x)); }
__device__ __forceinline__ float silu(float x) { return x / (1.f + __expf(-x)); }
__device__ __forceinline__ float wave_sum(float v) {
#pragma unroll
    for (int o = 1; o < 64; o <<= 1) v += __shfl_xor(v, o);
    return v;
}
__device__ __forceinline__ void unpack8(const v4u u, float (&f)[8]) {
    f[0] = bflo(u.x); f[1] = bfhi(u.x); f[2] = bflo(u.y); f[3] = bfhi(u.y); f[4] = bflo(u.z); f[5] = bfhi(u.z); f[6] = bflo(u.w); f[7] = bfhi(u.w);
}
__device__ __forceinline__ v4u pack8(const float (&f)[8]) { v4u u; u.x = pk(f[0], f[1]); u.y = pk(f[2], f[3]); u.z = pk(f[4], f[5]); u.w = pk(f[6], f[7]); return u; }

enum { E_Z = 0, E_POOL = 1, E_YA = 2, E_YB = 3, E_PLAIN = 4, E_SWIGLU = 5 };
template <int MODE> struct Epi {
    static constexpr bool PERM = true, AFTER_DRAIN = false;
    bf16* O; int ldc;
    const bf16* Gt;
    const bf16* Tin;
    const float* vec;
    bf16 *zP, *zQ, *zK, *zV, *zR, *zG;
    __device__ __forceinline__ void operator()(const f32x4 (&acc)[2][2][4][2], const Unit& u, int wr, int wc, int fr, int fq) const {
        const int row0 = u.pm * 256 + wr * 64 + fr, lc = wc * 32 + 8 * fq;
        if constexpr (MODE == E_SWIGLU) {
#pragma unroll
            for (int ai = 0; ai < 2; ++ai)
#pragma unroll
                for (int m = 0; m < 4; ++m) {
                    const f32x4 g0 = acc[ai][0][m][0], g1 = acc[ai][0][m][1], u0 = acc[ai][1][m][0], u1 = acc[ai][1][m][1];
                    v4u w; w.x = pk(silu(g0[0]) * u0[0], silu(g0[1]) * u0[1]); w.y = pk(silu(g0[2]) * u0[2], silu(g0[3]) * u0[3]);
                    w.z = pk(silu(g1[0]) * u1[0], silu(g1[1]) * u1[1]); w.w = pk(silu(g1[2]) * u1[2], silu(g1[3]) * u1[3]);
                    *(v4u*)(O + (size_t)(row0 + ai * 128 + m * 16) * ldc + u.pn * 128 + lc) = w; }
        } else {
            bf16* base = O; int ld = ldc, ct = u.pn * 256, op = 0;
            if constexpr (MODE == E_Z) {
                const int pn = u.pn;
                if (pn < 4) { base = zP; ld = 1024; ct = pn * 256; }
                else if (pn < 8) { base = zQ; ld = 1024; ct = (pn - 4) * 256; op = 1; }
                else if (pn < 12) { base = zK; ld = 1024; ct = (pn - 8) * 256; }
                else if (pn < 20) { base = zV; ld = 2048; ct = (pn - 12) * 256; }
                else if (pn < 28) { base = zR; ld = 2048; ct = (pn - 20) * 256; op = 2; }
                else { base = zG; ld = 4096; ct = (pn - 28) * 256; op = 3; }
            }
#pragma unroll
            for (int bj = 0; bj < 2; ++bj) {
                const int col = ct + bj * 128 + lc;
                f32x4 s0 = {1.f, 1.f, 1.f, 1.f}, s1 = s0;
                if constexpr (MODE == E_POOL) { s0 = *(const f32x4*)(vec + col); s1 = *(const f32x4*)(vec + col + 4); }
                if constexpr (MODE == E_Z) { if (op == 3) { s0 = *(const f32x4*)(vec + col); s1 = *(const f32x4*)(vec + col + 4); } }
#pragma unroll
                for (int ai = 0; ai < 2; ++ai)
#pragma unroll
                    for (int m = 0; m < 4; ++m) {
                        const size_t row = (size_t)(row0 + ai * 128 + m * 16);
                        f32x4 v0 = acc[ai][bj][m][0], v1 = acc[ai][bj][m][1];
                        if constexpr (MODE == E_POOL) { v0 = v0 * s0; v1 = v1 * s1; }
                        if constexpr (MODE == E_Z) {
                            if (op == 1) { v0 = v0 * 0.0625f; v1 = v1 * 0.0625f; }
                            else if (op == 2) { for (int i = 0; i < 4; ++i) { v0[i] = silu(v0[i]); v1[i] = silu(v1[i]); } }
                            else if (op == 3) { for (int i = 0; i < 4; ++i) { v0[i] = sigm(v0[i] + s0[i]); v1[i] = sigm(v1[i] + s1[i]); } }
                        }
                        if constexpr (MODE == E_YA || MODE == E_YB) {
                            float g[8]; unpack8(*(const v4u*)(Gt + row * 4096 + col), g);
                            for (int i = 0; i < 4; ++i) { v0[i] *= g[i]; v1[i] *= g[4 + i]; }
                            if constexpr (MODE == E_YB) { float t[8]; unpack8(*(const v4u*)(Tin + row * ld + col), t); for (int i = 0; i < 4; ++i) { v0[i] += t[i]; v1[i] += t[4 + i]; } }
                        }
                        v4u w; w.x = pk(v0[0], v0[1]); w.y = pk(v0[2], v0[3]); w.z = pk(v1[0], v1[1]); w.w = pk(v1[2], v1[3]);
                        *(v4u*)(base + row * ld + col) = w; }
            }
        }
    }
};

__device__ __forceinline__ void transpose_item(const float* W, int ldw, int K, int k0, int ns0, bf16* WT, int nd0, LAS float* scr, int lane) {
    float rr[32];
    const float* wp = W + (size_t)(k0 + (lane >> 5)) * ldw + ns0 + (lane & 31);
#pragma unroll
    for (int i = 0; i < 32; ++i) rr[i] = wp[(size_t)(2 * i) * ldw];
#pragma unroll
    for (int i = 0; i < 32; ++i) scr[(2 * i + (lane >> 5)) * 33 + (lane & 31)] = rr[i];
    LDS_WAIT(); asm volatile("" ::: "memory");
    const int c = lane & 7;
#pragma unroll
    for (int j = 0; j < 4; ++j) { const int n = (lane >> 3) + 8 * j; const LAS float* s = scr + (8 * c) * 33 + n;
        v4u o; o.x = pk(s[0 * 33], s[1 * 33]); o.y = pk(s[2 * 33], s[3 * 33]); o.z = pk(s[4 * 33], s[5 * 33]); o.w = pk(s[6 * 33], s[7 * 33]);
        *(v4u*)(WT + (size_t)(nd0 + n) * K + k0 + 8 * c) = o; }
    LDS_WAIT(); asm volatile("" ::: "memory");
}

__device__ __forceinline__ void phase0(const Args& a, LAS unsigned char* lds, int tid, int lane, int wave, int G) {
    unsigned char* ws = a.ws;
    LAS float* scr = (LAS float*)(lds + wave * 16384);
    const int gw = blockIdx.x * 8 + wave, NGW = G * 8;
    constexpr int I_IN = 32 * 352, I_GU = 32 * 176, I_D = 88 * 64, I_SQ = 32 * 64, I_A = 16 * 64, I_P = 4 * 4 * 8;
    constexpr int NITEMS = I_IN + 2 * I_GU + I_D + 2 * I_SQ + I_A + I_P;
    for (int it = gw; it < NITEMS; it += NGW) {
        int r = it;
        if (r < I_IN) { const int kb = r / 352, nb = r % 352, nd0 = 32 * nb, ns0 = nd0 < 5120 ? nd0 : nd0 + 16;
            transpose_item(a.in[2], DIN, D, 64 * kb, ns0, (bf16*)(ws + WS_WIN), nd0, scr, lane); continue; } r -= I_IN;
        if (r < I_GU) { const int kb = r / 176, nb = r % 176, c = 32 * nb, nd0 = (c >> 7) * 256 + (c & 127);
            transpose_item(a.in[14], FF, D, 64 * kb, c, (bf16*)(ws + WS_WGU), nd0, scr, lane); continue; } r -= I_GU;
        if (r < I_GU) { const int kb = r / 176, nb = r % 176, c = 32 * nb, nd0 = (c >> 7) * 256 + (c & 127) + 128;
            transpose_item(a.in[15], FF, D, 64 * kb, c, (bf16*)(ws + WS_WGU), nd0, scr, lane); continue; } r -= I_GU;
        if (r < I_D) { const int kb = r / 64, nb = r % 64;
            transpose_item(a.in[16], D, FF, 64 * kb, 32 * nb, (bf16*)(ws + WS_WD), 32 * nb, scr, lane); continue; } r -= I_D;
        if (r < I_SQ) { const int kb = r / 64, nb = r % 64;
            transpose_item(a.in[9], D, D, 64 * kb, 32 * nb, (bf16*)(ws + WS_WB), 32 * nb, scr, lane); continue; } r -= I_SQ;
        if (r < I_SQ) { const int kb = r / 64, nb = r % 64;
            transpose_item(a.in[11], D, D, 64 * kb, 32 * nb, (bf16*)(ws + WS_WOUT), 32 * nb, scr, lane); continue; } r -= I_SQ;
        if (r < I_A) { const int kb = r / 64, nb = r % 64;
            transpose_item(a.in[8], D, PW, 64 * kb, 32 * nb, (bf16*)(ws + WS_WA), 32 * nb, scr, lane); continue; } r -= I_A;
        { const int g = r / 32, rr = r % 32, kb = rr / 8, nb = rr % 8;
            transpose_item(a.in[5] + (size_t)g * 65536, 256, 256, 64 * kb, 32 * nb, (bf16*)(ws + WS_WP) + (size_t)g * 65536, 32 * nb, scr, lane); }
    }
    __syncthreads();
    LAS float* wgt = (LAS float*)lds;
    for (int e = tid; e < 2048 * 4; e += 512) { const int k = e >> 2, q4 = e & 3; const f32x4 v = *(const f32x4*)(a.in[2] + (size_t)k * DIN + 5120 + 4 * q4);
        wgt[(4 * q4 + 0) * 2048 + k] = v[0]; wgt[(4 * q4 + 1) * 2048 + k] = v[1]; wgt[(4 * q4 + 2) * 2048 + k] = v[2]; wgt[(4 * q4 + 3) * 2048 + k] = v[3]; }
    __syncthreads();
    f32x4 gn[8];
#pragma unroll
    for (int j = 0; j < 8; ++j) gn[j] = *(const f32x4*)(a.in[1] + 256 * j + 4 * lane);
    bf16* XN = (bf16*)(ws + WS_XN); float* glr = (float*)(ws + WS_GLR);
    typedef float f32x2 __attribute__((ext_vector_type(2)));
    f32x4 na[8], nb[8];
    if (gw < M / 2) {
#pragma unroll
        for (int j = 0; j < 8; ++j) { na[j] = *(const f32x4*)(a.in[0] + (size_t)(2 * gw) * D + 256 * j + 4 * lane); nb[j] = *(const f32x4*)(a.in[0] + (size_t)(2 * gw + 1) * D + 256 * j + 4 * lane); }
    }
    const int hi = lane >> 5;
    for (int pr = gw; pr < M / 2; pr += NGW) {
        const size_t ra = 2 * (size_t)pr, rb = ra + 1;
        f32x2 xab[8][4]; float ssa = 0.f, ssb = 0.f;
#pragma unroll
        for (int j = 0; j < 8; ++j) {
            const f32x4 va = na[j], vb = nb[j];
            ssa += (va[0] * va[0] + va[1] * va[1]) + (va[2] * va[2] + va[3] * va[3]); ssb += (vb[0] * vb[0] + vb[1] * vb[1]) + (vb[2] * vb[2] + vb[3] * vb[3]);
#pragma unroll
            for (int i = 0; i < 4; ++i) xab[j][i] = (f32x2){va[i] * gn[j][i], vb[i] * gn[j][i]}; }
        { const int nx = (pr + NGW < M / 2) ? pr + NGW : pr;
#pragma unroll
          for (int j = 0; j < 8; ++j) { na[j] = *(const f32x4*)(a.in[0] + (size_t)(2 * nx) * D + 256 * j + 4 * lane); nb[j] = *(const f32x4*)(a.in[0] + (size_t)(2 * nx + 1) * D + 256 * j + 4 * lane); } }
        const float rsa = rsqrtf(wave_sum(ssa) * (1.f / D) + EPS), rsb = rsqrtf(wave_sum(ssb) * (1.f / D) + EPS);
#pragma unroll
        for (int j = 0; j < 8; ++j) { v2u wa, wb; wa.x = pk(xab[j][0].x * rsa, xab[j][1].x * rsa); wa.y = pk(xab[j][2].x * rsa, xab[j][3].x * rsa); wb.x = pk(xab[j][0].y * rsb, xab[j][1].y * rsb); wb.y = pk(xab[j][2].y * rsb, xab[j][3].y * rsb);
            *(v2u*)(XN + ra * D + 256 * j + 4 * lane) = wa; *(v2u*)(XN + rb * D + 256 * j + 4 * lane) = wb; }
        float v[16];
#pragma unroll
        for (int jj = 0; jj < 16; ++jj) { f32x2 s0 = {0.f, 0.f}, s1 = {0.f, 0.f};
#pragma unroll
            for (int j = 0; j < 8; ++j) { const f32x4 w = *(const LAS f32x4*)(wgt + jj * 2048 + 256 * j + 4 * lane);
                s0 = xab[j][0] * w[0] + s0; s1 = xab[j][1] * w[1] + s1; s0 = xab[j][2] * w[2] + s0; s1 = xab[j][3] * w[3] + s1; }
            s0 = s0 + s1;
            const float mine = hi ? s0.y : s0.x, send = hi ? s0.x : s0.y;
            v[jj] = mine + __shfl_xor(send, 32); }
#pragma unroll
        for (int st = 0; st < 4; ++st) { const int n = 8 >> st, msk = 16 >> st; const bool b = (lane & msk) != 0;
#pragma unroll
            for (int i = 0; i < n; ++i) { const float mine = b ? v[i + n] : v[i], send = b ? v[i] : v[i + n]; v[i] = mine + __shfl_xor(send, msk); } }
        v[0] += __shfl_xor(v[0], 1);
        if ((lane & 1) == 0) glr[(ra + hi) * 16 + ((lane >> 1) & 15)] = v[0] * (hi ? rsb : rsa);
    }
}

template <int W> __device__ __forceinline__ void pool_block(const bf16* P, bf16* Dd, int tblk, int c8) {
    const int t0 = tblk * 8, pos0 = t0 & (T - 1);
    constexpr int R = W + 7;
    v4u rows[R];
#pragma unroll
    for (int r = 0; r < R; ++r) { const int dt = r - (W - 1); const bool valid = (pos0 + dt) >= 0;
        rows[r] = valid ? *(const v4u*)(P + (size_t)(t0 + dt) * 1024 + c8 * 8) : (v4u){0u, 0u, 0u, 0u}; }
    float s[8];
#pragma unroll
    for (int i = 0; i < 8; ++i) s[i] = 0.f;
#pragma unroll
    for (int r = 0; r < W - 1; ++r) { float f[8]; unpack8(rows[r], f);
#pragma unroll
        for (int i = 0; i < 8; ++i) s[i] += f[i]; }
#pragma unroll
    for (int o = 0; o < 8; ++o) {
        float cur[8]; unpack8(rows[o + W - 1], cur);
#pragma unroll
        for (int i = 0; i < 8; ++i) s[i] += cur[i];
        const int cnt = (pos0 + o + 1 < W) ? pos0 + o + 1 : W; const float inv = 1.f / (float)cnt;
        float d[8];
#pragma unroll
        for (int i = 0; i < 8; ++i) d[i] = s[i] * inv - cur[i];
        *(v4u*)(Dd + (size_t)(t0 + o) * 1024 + c8 * 8) = pack8(d);
        float old[8]; unpack8(rows[o], old);
#pragma unroll
        for (int i = 0; i < 8; ++i) s[i] -= old[i];
    }
}
__device__ __forceinline__ void pool_diff(const bf16* P, bf16* Dd, int lane, int wave, int G) {
    const int gw = blockIdx.x * 8 + wave, NGW = G * 8;
    for (int wi = gw; wi < 4 * (M / 16); wi += NGW) {
        const int g = (wi + (wi >> 11)) & 3, tp = wi >> 2, tblk = 2 * tp + (lane >> 5), c8 = g * 32 + (lane & 31);
        if (g == 0) pool_block<2>(P, Dd, tblk, c8); else if (g == 1) pool_block<4>(P, Dd, tblk, c8); else if (g == 2) pool_block<8>(P, Dd, tblk, c8); else pool_block<16>(P, Dd, tblk, c8);
    }
}

__device__ __forceinline__ void gla_prepass(const Args& a, LAS unsigned char* lds, int tid, int lane, int wave, int G) {
    unsigned char* ws = a.ws;
    constexpr int QS = 0, KS = 33792, WU = 67584;
    const bf16* Q = (const bf16*)(ws + Z_Q); bf16* Qp = (bf16*)(ws + WS_QP); const bf16* Kb = (const bf16*)(ws + Z_K); bf16* KdT = (bf16*)(ws + WS_KDT);
    bf16* Amat = (bf16*)((unsigned char*)a.out + DO_AMAT); float* avec = (float*)((unsigned char*)a.out + DO_AVEC);
    const float* glr = (const float*)(ws + WS_GLR);
    const int l15 = lane & 15, g4 = lane >> 4;
    for (int it = blockIdx.x; it < 2048; it += G) {
        const int bh = it >> 7, c = it & 127, b = bh >> 2, h = bh & 3; const size_t t0 = (size_t)b * T + (size_t)c * 64;
        const size_t trow = t0 + lane; const int kc0 = h * 256 + 32 * wave;
        f32x4 gl[4];
#pragma unroll
        for (int i = 0; i < 4; ++i) gl[i] = *(const f32x4*)(glr + trow * 16 + 4 * i);
        v4u qv[4], kv[4];
#pragma unroll
        for (int i = 0; i < 4; ++i) { qv[i] = *(const v4u*)(Q + trow * 1024 + kc0 + 8 * i); kv[i] = *(const v4u*)(Kb + trow * 1024 + kc0 + 8 * i); }
        for (int e = tid; e < 17 * 64; e += 512) { const int jr = e >> 6, c4 = (e & 63) * 4;
            const f32x4 v = (jr < 16) ? *(const f32x4*)(a.in[3] + jr * 1024 + h * 256 + c4) : *(const f32x4*)(a.in[4] + h * 256 + c4);
            *(LAS f32x4*)(lds + WU + (jr * 256 + c4) * 4) = v; }
        __syncthreads();
        float Gc[32];
#pragma unroll
        for (int q8 = 0; q8 < 8; ++q8) {
            f32x4 z = *(const LAS f32x4*)(lds + WU + (16 * 256 + 32 * wave + 4 * q8) * 4);
#pragma unroll
            for (int jr = 0; jr < 16; ++jr) { const f32x4 w = *(const LAS f32x4*)(lds + WU + (jr * 256 + 32 * wave + 4 * q8) * 4); z = z + w * gl[jr >> 2][jr & 3]; }
#pragma unroll
            for (int i = 0; i < 4; ++i) { const float zz = z[i]; Gc[4 * q8 + i] = (fminf(zz, 0.f) - __logf(1.f + __expf(-fabsf(zz)))) * 0.0625f; }
        }
#pragma unroll
        for (int d = 1; d < 64; d <<= 1) {
#pragma unroll
            for (int cc = 0; cc < 32; ++cc) { const float up = __shfl_up(Gc[cc], d); Gc[cc] += (lane >= d) ? up : 0.f; } }
        float kd[32]; unsigned qpk[16], kpk[16];
#pragma unroll
        for (int i = 0; i < 4; ++i) { float qf[8], kf[8]; unpack8(qv[i], qf); unpack8(kv[i], kf);
#pragma unroll
            for (int e = 0; e < 8; ++e) { const int cc = 8 * i + e; const float Gv = Gc[cc], Gl = __shfl(Gv, 63);
                const float eg = __expf(Gv), ie = __expf(-Gv);
                qf[e] = qf[e] * eg; kd[cc] = kf[e] * __expf(Gl - Gv); kf[e] = kf[e] * ie;
                if (lane == 63) Gc[cc] = eg; }
            const v4u qo = pack8(qf), ko = pack8(kf);
            *(v4u*)(Qp + trow * 1024 + kc0 + 8 * i) = qo;
            *(LAS v4u*)(lds + QS + lane * 528 + (32 * wave + 8 * i) * 2) = qo; *(LAS v4u*)(lds + KS + lane * 528 + (32 * wave + 8 * i) * 2) = ko; }
        if (lane == 63) {
#pragma unroll
            for (int i = 0; i < 8; ++i) *(f32x4*)(avec + (size_t)it * 256 + 32 * wave + 4 * i) = (f32x4){Gc[4 * i], Gc[4 * i + 1], Gc[4 * i + 2], Gc[4 * i + 3]}; }
#pragma unroll
        for (int cc = 0; cc < 32; cc += 2) { const unsigned p2 = pk(kd[cc], kd[cc + 1]);
            KdT[((size_t)it * 256 + 32 * wave + cc) * 64 + lane] = (unsigned short)(p2 & 0xffffu); KdT[((size_t)it * 256 + 32 * wave + cc + 1) * 64 + lane] = (unsigned short)(p2 >> 16); }
        __syncthreads();
        const int jt = wave >> 1, it0 = 2 * (wave & 1);
        f32x4 c0 = {0.f, 0.f, 0.f, 0.f}, c1 = c0;
#pragma unroll
        for (int kk = 0; kk < 8; ++kk) {
            const bf16x8 av = *(const LAS bf16x8*)(lds + KS + (16 * jt + l15) * 528 + (32 * kk + 8 * g4) * 2);
            const bf16x8 b0 = *(const LAS bf16x8*)(lds + QS + (16 * it0 + l15) * 528 + (32 * kk + 8 * g4) * 2);
            const bf16x8 b1 = *(const LAS bf16x8*)(lds + QS + (16 * it0 + 16 + l15) * 528 + (32 * kk + 8 * g4) * 2);
            c0 = __builtin_amdgcn_mfma_f32_16x16x32_bf16(av, b0, c0, 0, 0, 0); c1 = __builtin_amdgcn_mfma_f32_16x16x32_bf16(av, b1, c1, 0, 0, 0); }
        { const int jb = 16 * jt + 4 * g4; const int i0 = 16 * it0 + l15, i1 = i0 + 16;
          v2u w0, w1;
          w0.x = pk(jb + 0 <= i0 ? c0[0] : 0.f, jb + 1 <= i0 ? c0[1] : 0.f); w0.y = pk(jb + 2 <= i0 ? c0[2] : 0.f, jb + 3 <= i0 ? c0[3] : 0.f);
          w1.x = pk(jb + 0 <= i1 ? c1[0] : 0.f, jb + 1 <= i1 ? c1[1] : 0.f); w1.y = pk(jb + 2 <= i1 ? c1[2] : 0.f, jb + 3 <= i1 ? c1[3] : 0.f);
          *(v2u*)(Amat + (size_t)it * 4096 + i0 * 64 + jb) = w0; *(v2u*)(Amat + (size_t)it * 4096 + i1 * 64 + jb) = w1; }
        __syncthreads();
    }
}

__device__ __forceinline__ void gla_seq(const Args& a, LAS unsigned char* lds, int tid, int lane, int wave, int G, int vc) {
    unsigned char* ws = a.ws;
    constexpr int QS = 0, KT = 33792, AS = 70656, VT = 79872, ST = 84480, AV = 101376;
    const bf16* Q = (const bf16*)(ws + WS_QP); const bf16* KdT = (const bf16*)(ws + WS_KDT); const bf16* V = (const bf16*)(ws + Z_V); bf16* Ob = (bf16*)((unsigned char*)a.out + DO_O);
    const bf16* Amat = (const bf16*)((unsigned char*)a.out + DO_AMAT); const float* avec = (const float*)((unsigned char*)a.out + DO_AVEC);
    const int l15 = lane & 15, g4 = lane >> 4;
    for (int it = vc; it < 256; it += G) {
        const int vi = (it & 7) * 32 + (it >> 3), bh = vi >> 4, vs = vi & 15, b = bh >> 2, h = bh & 3;
        const size_t tb = (size_t)b * T;
        const bf16* qbase = Q + tb * 1024 + h * 256;
        const bf16* ktbase = KdT + (size_t)bh * 128 * 16384;
        const bf16* abase = Amat + (size_t)bh * 128 * 4096;
        const float* avbase = avec + (size_t)bh * 128 * 256;
        const bf16* vbase = V + tb * 2048 + h * 512 + vs * 32; bf16* obase = Ob + tb * 2048 + h * 512 + vs * 32;
        for (int e = tid; e < 16896 / 4; e += 512) ((LAS unsigned*)(lds + ST))[e] = 0u;
        f32x4 sacc[2][2];
#pragma unroll
        for (int i = 0; i < 2; ++i)
#pragma unroll
            for (int j = 0; j < 2; ++j) sacc[i][j] = (f32x4){0.f, 0.f, 0.f, 0.f};
        v4u rq0[4], rk0[4], ra0, rq1[4], rk1[4], ra1; v2u rv0, rv1; f32x4 rav0 = {0.f, 0.f, 0.f, 0.f}, rav1 = rav0;
#define GLA_LOAD(cc, S) do { \
        _Pragma("unroll") for (int r = 0; r < 4; ++r) { const int e = tid + 512 * r; rq##S[r] = *(const v4u*)(qbase + (size_t)((cc) * 64 + (e >> 5)) * 1024 + (e & 31) * 8); } \
        _Pragma("unroll") for (int r = 0; r < 4; ++r) rk##S[r] = *(const v4u*)(ktbase + (size_t)(cc) * 16384 + (size_t)(tid + 512 * r) * 8); \
        ra##S = *(const v4u*)(abase + (size_t)(cc) * 4096 + tid * 8); \
        rv##S = *(const v2u*)(vbase + (size_t)((cc) * 64 + (tid >> 3)) * 2048 + (tid & 7) * 4); \
        rav##S = *(const f32x4*)(avbase + (cc) * 256 + (tid & 63) * 4); } while (0)
#define GLA_STEP(c, S) do { \
            _Pragma("unroll") for (int r = 0; r < 4; ++r) { const int e = tid + 512 * r; *(LAS v4u*)(lds + QS + (e >> 5) * 528 + (e & 31) * 16) = rq##S[r]; *(LAS v4u*)(lds + KT + (e >> 3) * 144 + (e & 7) * 16) = rk##S[r]; } \
            *(LAS v4u*)(lds + AS + (tid >> 3) * 144 + (tid & 7) * 16) = ra##S; \
            { LAS unsigned short* vt = (LAS unsigned short*)(lds + VT); const int j = tid >> 3, n0 = 4 * (tid & 7); \
              vt[(n0 + 0) * 72 + j] = (unsigned short)(rv##S.x & 0xffffu); vt[(n0 + 1) * 72 + j] = (unsigned short)(rv##S.x >> 16); \
              vt[(n0 + 2) * 72 + j] = (unsigned short)(rv##S.y & 0xffffu); vt[(n0 + 3) * 72 + j] = (unsigned short)(rv##S.y >> 16); } \
            if (tid < 64) *(LAS f32x4*)(lds + AV + tid * 16) = rav##S; \
            BAR_LDS(); \
            GLA_LOAD(((c) + 2 < NCH ? (c) + 2 : NCH - 1), S); \
            { const int nt = wave & 1, itl = wave >> 1; \
              f32x4 oa = {0.f, 0.f, 0.f, 0.f}, ob = oa; \
              _Pragma("unroll") for (int kk = 0; kk < 8; kk += 2) { \
                  const bf16x8 a0 = *(const LAS bf16x8*)(lds + ST + (16 * nt + l15) * 528 + (32 * kk + 8 * g4) * 2), b0 = *(const LAS bf16x8*)(lds + QS + (16 * itl + l15) * 528 + (32 * kk + 8 * g4) * 2); \
                  const bf16x8 a1 = *(const LAS bf16x8*)(lds + ST + (16 * nt + l15) * 528 + (32 * kk + 32 + 8 * g4) * 2), b1 = *(const LAS bf16x8*)(lds + QS + (16 * itl + l15) * 528 + (32 * kk + 32 + 8 * g4) * 2); \
                  oa = __builtin_amdgcn_mfma_f32_16x16x32_bf16(a0, b0, oa, 0, 0, 0); ob = __builtin_amdgcn_mfma_f32_16x16x32_bf16(a1, b1, ob, 0, 0, 0); } \
              { const bf16x8 a0 = *(const LAS bf16x8*)(lds + VT + (16 * nt + l15) * 144 + (8 * g4) * 2), b0 = *(const LAS bf16x8*)(lds + AS + (16 * itl + l15) * 144 + (8 * g4) * 2); \
                const bf16x8 a1 = *(const LAS bf16x8*)(lds + VT + (16 * nt + l15) * 144 + (32 + 8 * g4) * 2), b1 = *(const LAS bf16x8*)(lds + AS + (16 * itl + l15) * 144 + (32 + 8 * g4) * 2); \
                oa = __builtin_amdgcn_mfma_f32_16x16x32_bf16(a0, b0, oa, 0, 0, 0); ob = __builtin_amdgcn_mfma_f32_16x16x32_bf16(a1, b1, ob, 0, 0, 0); } \
              oa = oa + ob; \
              v2u w; w.x = pk_c(oa[0], oa[1]); w.y = pk_c(oa[2], oa[3]); \
              *(v2u*)(obase + (size_t)((c) * 64 + 16 * itl + l15) * 2048 + 16 * nt + 4 * g4) = w; } \
            asm volatile("" ::: "memory"); \
            _Pragma("unroll") for (int kt = 0; kt < 2; ++kt) { \
                const f32x4 dec = *(const LAS f32x4*)(lds + AV + (32 * wave + 16 * kt + 4 * g4) * 4); \
                const bf16x8 ka0 = *(const LAS bf16x8*)(lds + KT + (32 * wave + 16 * kt + l15) * 144 + (8 * g4) * 2), ka1 = *(const LAS bf16x8*)(lds + KT + (32 * wave + 16 * kt + l15) * 144 + (32 + 8 * g4) * 2); \
                _Pragma("unroll") for (int nt = 0; nt < 2; ++nt) { \
                    const bf16x8 vb0 = *(const LAS bf16x8*)(lds + VT + (16 * nt + l15) * 144 + (8 * g4) * 2), vb1 = *(const LAS bf16x8*)(lds + VT + (16 * nt + l15) * 144 + (32 + 8 * g4) * 2); \
                    f32x4 sv = sacc[kt][nt] * dec; \
                    sv = __builtin_amdgcn_mfma_f32_16x16x32_bf16(ka0, vb0, sv, 0, 0, 0); sv = __builtin_amdgcn_mfma_f32_16x16x32_bf16(ka1, vb1, sv, 0, 0, 0); \
                    sacc[kt][nt] = sv; } } \
            BAR_LDS(); \
            _Pragma("unroll") for (int kt = 0; kt < 2; ++kt) \
                _Pragma("unroll") for (int nt = 0; nt < 2; ++nt) { const f32x4 sv = sacc[kt][nt]; v2u w; w.x = pk_c(sv[0], sv[1]); w.y = pk_c(sv[2], sv[3]); \
                    *(LAS v2u*)(lds + ST + (16 * nt + l15) * 528 + (32 * wave + 16 * kt + 4 * g4) * 2) = w; } \
        } while (0)
        GLA_LOAD(0, 0); GLA_LOAD(1, 1);
        for (int c = 0; c < NCH; c += 2) { GLA_STEP(c, 0); GLA_STEP(c + 1, 1); }
#undef GLA_LOAD
#undef GLA_STEP
        __syncthreads();
    }
}

__device__ __forceinline__ void on_pass(const Args& a, int lane, int wave, int G) {
    const bf16* O = (const bf16*)((unsigned char*)a.out + DO_O); bf16* ON = (bf16*)(a.ws + Z_V); const bf16* R = (const bf16*)(a.ws + Z_R);
    const f32x4 gA = *(const f32x4*)(a.in[7] + 8 * lane), gB = *(const f32x4*)(a.in[7] + 8 * lane + 4);
    const int gw = blockIdx.x * 8 + wave, NGW = G * 8;
    v4u ov[4], rv[4];
    if (gw < M) {
#pragma unroll
        for (int j = 0; j < 4; ++j) { ov[j] = *(const v4u*)(O + (size_t)gw * 2048 + 8 * lane + 512 * j); rv[j] = *(const v4u*)(R + (size_t)gw * 2048 + 8 * lane + 512 * j); }
    }
    for (int row = gw; row < M; row += NGW) {
        bf16* on = ON + (size_t)row * 2048 + 8 * lane;
        v4u oc[4], rc[4];
#pragma unroll
        for (int j = 0; j < 4; ++j) { oc[j] = ov[j]; rc[j] = rv[j]; }
        { const int nx = (row + NGW < M) ? row + NGW : row;
#pragma unroll
          for (int j = 0; j < 4; ++j) { ov[j] = *(const v4u*)(O + (size_t)nx * 2048 + 8 * lane + 512 * j); rv[j] = *(const v4u*)(R + (size_t)nx * 2048 + 8 * lane + 512 * j); } }
#pragma unroll
        for (int j = 0; j < 4; ++j) { float f[8], s[8]; unpack8(oc[j], f); unpack8(rc[j], s); float ss = 0.f;
#pragma unroll
            for (int i = 0; i < 8; ++i) ss += f[i] * f[i];
            const float rs = rsqrtf(wave_sum(ss) * (1.f / 512.f) + EPS);
#pragma unroll
            for (int i = 0; i < 4; ++i) { f[i] = f[i] * rs * gA[i] * s[i]; f[4 + i] = f[4 + i] * rs * gB[i] * s[4 + i]; }
            *(v4u*)(on + 512 * j) = pack8(f); }
    }
}
template <int MODE> __device__ __forceinline__ void res_pass(const float* xin, const bf16* U, const float* g1p, const float* g2p, float* out, bf16* H2, int lane, int wave, int G) {
    f32x4 g1[4][2], g2[4][2];
#pragma unroll
    for (int j = 0; j < 4; ++j)
#pragma unroll
        for (int q = 0; q < 2; ++q) { g1[j][q] = *(const f32x4*)(g1p + 512 * j + 8 * lane + 4 * q); if (MODE == 0) g2[j][q] = *(const f32x4*)(g2p + 512 * j + 8 * lane + 4 * q); }
    const int gw = blockIdx.x * 8 + wave, NGW = G * 8;
    for (int row = gw; row < M; row += NGW) {
        const size_t ro = (size_t)row * 2048 + 8 * lane;
        v4u uv[4]; f32x4 xv[4][2];
#pragma unroll
        for (int j = 0; j < 4; ++j) { uv[j] = *(const v4u*)(U + ro + 512 * j); xv[j][0] = *(const f32x4*)(xin + ro + 512 * j); xv[j][1] = *(const f32x4*)(xin + ro + 512 * j + 4); }
        float uf[4][8]; float ss = 0.f;
#pragma unroll
        for (int j = 0; j < 4; ++j) { unpack8(uv[j], uf[j]);
#pragma unroll
            for (int i = 0; i < 8; ++i) ss += uf[j][i] * uf[j][i]; }
        const float rs = rsqrtf(wave_sum(ss) * (1.f / 2048.f) + EPS);
        float s1 = 0.f;
#pragma unroll
        for (int j = 0; j < 4; ++j)
#pragma unroll
            for (int q = 0; q < 2; ++q)
#pragma unroll
                for (int i = 0; i < 4; ++i) { const float v = xv[j][q][i] + uf[j][4 * q + i] * rs * g1[j][q][i]; xv[j][q][i] = v; s1 += v * v; }
#pragma unroll
        for (int j = 0; j < 4; ++j) { *(f32x4*)(out + ro + 512 * j) = xv[j][0]; *(f32x4*)(out + ro + 512 * j + 4) = xv[j][1]; }
        if (MODE == 0) {
            const float r1 = rsqrtf(wave_sum(s1) * (1.f / 2048.f) + EPS);
#pragma unroll
            for (int j = 0; j < 4; ++j) { float f[8];
#pragma unroll
                for (int i = 0; i < 4; ++i) { f[i] = xv[j][0][i] * r1 * g2[j][0][i]; f[4 + i] = xv[j][1][i] * r1 * g2[j][1][i]; }
                *(v4u*)(H2 + ro + 512 * j) = pack8(f); }
        }
    }
}

#define XB_TMO      128
#define XB_XCNT(j)  (256  + 64 * (j))
#define XB_XSUB(j)  (1280 + 64 * (j))
#define XB_XGEN(j)  (2304 + 64 * (j))
#define XB_TOP      3328
#define XB_TOPGEN   3392
#define XCD_BAR_WORDS 3456
#define XB_SPIN_CAP (1u << 18)

__device__ __forceinline__ unsigned xb_ld(unsigned* p)              { return __hip_atomic_load(p, __ATOMIC_RELAXED, __HIP_MEMORY_SCOPE_AGENT); }
__device__ __forceinline__ unsigned xb_add(unsigned* p, unsigned v) { return __hip_atomic_fetch_add(p, v, __ATOMIC_RELAXED, __HIP_MEMORY_SCOPE_AGENT); }
__device__ __forceinline__ unsigned xb_xcc_id() { return (unsigned)__builtin_amdgcn_s_getreg((3 << 11) | 20) & 0xFu; }
#define XB_SPIN(cond, bar) do { unsigned _sp = 0; while (cond) { __builtin_amdgcn_s_sleep(1); \
    if ((++_sp & 255u) == 0u) { if (xb_ld(&(bar)[XB_TMO])) break; if (_sp > XB_SPIN_CAP) { atomicAdd(&(bar)[XB_TMO], 1u); break; } } } } while (0)

struct XcdBarrier {
    unsigned* bar; unsigned x;
    volatile LAS unsigned* st;
};

__device__ __forceinline__ void xcd_barrier_post(unsigned* bar, bool t0) {
    if (t0) (void)xb_add(&bar[XB_XCNT(xb_xcc_id())], 1u);
}
__device__ __forceinline__ void xcd_barrier_complete(unsigned* bar, unsigned x, unsigned& nloc, unsigned& nx) {
    const unsigned G = gridDim.x * gridDim.y * gridDim.z;
    unsigned sum, cnt, mine, sp = 0u;
    for (;;) {
        sum = 0u; cnt = 0u; mine = 0u;
#pragma unroll
        for (unsigned j = 0; j < 16; ++j) { const unsigned c = xb_ld(&bar[XB_XCNT(j)]); sum += c; cnt += (c > 0u) ? 1u : 0u; mine = (j == x) ? c : mine; }
        if (sum == G) break;
        __builtin_amdgcn_s_sleep(1);
        if ((++sp & 255u) == 0u) { if (xb_ld(&bar[XB_TMO])) break; if (sp > XB_SPIN_CAP) { atomicAdd(&bar[XB_TMO], 1u); break; } }
    }
    nloc = mine > 0u ? mine : 1u; nx = cnt > 0u ? cnt : 1u;
}

__device__ __forceinline__ void xcd_barrier(const XcdBarrier& b, const bool t0) {
    asm volatile("s_waitcnt vmcnt(0)" ::: "memory");
    __syncthreads();
    if (t0) {
        unsigned* bar = b.bar;
        __builtin_amdgcn_s_waitcnt(0);
        unsigned nloc = b.st[0], nx = b.st[1];
        if (nloc == 0u) { xcd_barrier_complete(bar, b.x, nloc, nx); b.st[0] = nloc; b.st[1] = nx; }
        const unsigned old = xb_add(&bar[XB_XSUB(b.x)], 1u);
        const unsigned gen = old / nloc;
        if (old + 1u == (gen + 1u) * nloc) {
            __builtin_amdgcn_fence(__ATOMIC_RELEASE, "agent");
            asm volatile("s_waitcnt vmcnt(0)" ::: "memory");
            const unsigned og = xb_add(&bar[XB_TOP], 1u);
            const unsigned tg = og / nx;
            if (og + 1u == (tg + 1u) * nx) xb_add(&bar[XB_TOPGEN], 1u);
            else XB_SPIN(xb_ld(&bar[XB_TOPGEN]) == tg, bar);
            __builtin_amdgcn_fence(__ATOMIC_ACQUIRE, "agent");
            xb_add(&bar[XB_XGEN(b.x)], 1u);
            asm volatile("s_waitcnt vmcnt(0)" ::: "memory");
        } else {
            XB_SPIN(xb_ld(&bar[XB_XGEN(b.x)]) == gen, bar);
            __builtin_amdgcn_fence(__ATOMIC_ACQUIRE, "agent");
            asm volatile("s_waitcnt vmcnt(0)" ::: "memory");
        }
    }
    __syncthreads();
}

#ifndef PH_MASK
#define PH_MASK 0xffff
#endif
#define PH(n) ((PH_MASK >> (n)) & 1)
#ifndef DBL_MASK
#define DBL_MASK 0x0
#endif
#define REP(k) (((DBL_MASK >> (k)) & 1) ? 2 : 1)
#define RUN(k, ...) for (int rep_ = 0; rep_ < REP(k); ++rep_) { if (rep_) { __syncthreads(); grid.sync(); } __VA_ARGS__ }
typedef const __attribute__((address_space(4))) Args* ArgsP;
__device__ __forceinline__ ArgsP get_args() { ArgsP p = (ArgsP)__builtin_amdgcn_kernarg_segment_ptr(); asm volatile("" : "+s"(p)); return p; }
__global__ void __launch_bounds__(512, 2) fwd_kernel(Args a_unused) {
    extern __shared__ __attribute__((aligned(16))) unsigned char lds_raw[];
    LAS unsigned char* lds = (LAS unsigned char*)lds_raw;
    cg::grid_group grid = cg::this_grid();
    const int wave_s = __builtin_amdgcn_readfirstlane(threadIdx.x >> 6); int tid, lane, wave; const int G = gridDim.x;
#define LAUNDER() do { unsigned m_ = ~0u; int w_ = wave_s; asm volatile("" : "+s"(m_), "+s"(w_)); lane = (int)__builtin_amdgcn_mbcnt_hi(m_, __builtin_amdgcn_mbcnt_lo(m_, 0u)); wave = w_; tid = (wave << 6) | lane; } while (0)
    { ArgsP ap0 = get_args(); unsigned* ctl = (unsigned*)(ap0->ws + WS_CTL);
      if (threadIdx.x == 0) { const unsigned xcc = (unsigned)__builtin_amdgcn_s_getreg((3 << 11) | 20) & 0xFu; const unsigned rank = atomicAdd(ctl + 64 * (xcc & 7u), 1u);
          volatile LAS unsigned* lc = (volatile LAS unsigned*)(lds + LDS_CTL); lc[0] = xcc; lc[1] = rank; lc[2] = blockIdx.x; lc[8] = 0u; lc[9] = 0u; }
      xcd_barrier_post((unsigned*)(ap0->ws + WS_CTL + CTL_BAR_OFF), threadIdx.x == 0); }
#define GRID_BAR() do { XcdBarrier xb_; xb_.bar = (unsigned*)(get_args()->ws + WS_CTL + CTL_BAR_OFF); xb_.x = xb_xcc_id(); xb_.st = (volatile LAS unsigned*)(lds + LDS_CTL) + 8; xcd_barrier(xb_, wave_s == 0 && __builtin_amdgcn_mbcnt_hi(~0u, __builtin_amdgcn_mbcnt_lo(~0u, 0u)) == 0u); } while (0)
#define PHASE_ARGS() ArgsP ap_ = get_args(); Args a; _Pragma("unroll") for (int i_ = 0; i_ < 18; ++i_) a.in[i_] = ap_->in[i_]; a.out = ap_->out; a.ws = ap_->ws; unsigned char* const ws = a.ws; (void)ws; const int vc = __builtin_amdgcn_readfirstlane((int)((volatile LAS unsigned*)(lds + LDS_CTL))[2]); (void)vc
    typedef pg8::StaticOrder SO;
#if PH(0)
    LAUNDER();
    { PHASE_ARGS();
    RUN(0, phase0(a, lds, tid, lane, wave, G); )
    }
#endif
    grid.sync();
    { ArgsP ap0 = get_args(); unsigned* ctl = (unsigned*)(ap0->ws + WS_CTL);
      if (threadIdx.x == 0) { volatile LAS unsigned* lc = (volatile LAS unsigned*)(lds + LDS_CTL); bool ok = (G % 8) == 0;
          for (int x = 0; x < 8; ++x) ok = ok && (__hip_atomic_load(ctl + 64 * x, __ATOMIC_RELAXED, __HIP_MEMORY_SCOPE_AGENT) == (unsigned)(G / 8));
          const unsigned xcc = lc[0], rank = lc[1]; lc[2] = (ok && xcc < 8u) ? xcc + 8u * rank : blockIdx.x; }
      __syncthreads(); }
#if PH(1)
    LAUNDER();
    { PHASE_ARGS();
    RUN(1, { pg8::Gemm g{(const bf16*)(ws + WS_XN), (const bf16*)(ws + WS_WIN), D, D, D, 0}; SO S; S.init(M, NZ, G, vc);
      Epi<E_Z> E{}; E.vec = a.in[10]; E.zP = (bf16*)(ws + Z_P); E.zQ = (bf16*)(ws + Z_Q); E.zK = (bf16*)(ws + Z_K); E.zV = (bf16*)(ws + Z_V); E.zR = (bf16*)(ws + Z_R); E.zG = (bf16*)(ws + Z_G);
      pg8::gemm_phase<Epi<E_Z>, SO, true, true>(lds, g, S, E, tid); } )
    }
#endif
    GRID_BAR();
#if PH(2)
    LAUNDER();
    { PHASE_ARGS();
    RUN(2, pool_diff((const bf16*)(ws + Z_P), (bf16*)((unsigned char*)a.out + DO_DIFF), lane, wave, G); )
    RUN(3, gla_prepass(a, lds, tid, lane, wave, G); )
    }
#endif
    GRID_BAR();
#if PH(3)
    LAUNDER();
    { PHASE_ARGS();
    RUN(4, gla_seq(a, lds, tid, lane, wave, G, vc); )
    RUN(5, { pg8::Gemm g{(const bf16*)((unsigned char*)a.out + DO_DIFF), (const bf16*)(ws + WS_WP), PW, 256, 256, 512}; SO S; S.init(M, PW, G, vc);
      Epi<E_POOL> E{}; E.O = (bf16*)(ws + Z_P); E.ldc = PW; E.vec = a.in[6];
      pg8::gemm_phase<Epi<E_POOL>, SO, true, true>(lds, g, S, E, tid); } )
    }
#endif
    GRID_BAR();
#if PH(4)
    LAUNDER();
    { PHASE_ARGS();
    RUN(6, on_pass(a, lane, wave, G); )
    RUN(7, { pg8::Gemm g{(const bf16*)(ws + Z_P), (const bf16*)(ws + WS_WA), PW, PW, PW, 0}; SO S; S.init(M, D, G, vc);
      Epi<E_YA> E{}; E.O = (bf16*)(ws + WS_T); E.ldc = D; E.Gt = (const bf16*)(ws + Z_G);
      pg8::gemm_phase<Epi<E_YA>, SO, true, true>(lds, g, S, E, tid); } )
    }
#endif
    GRID_BAR();
#if PH(5)
    LAUNDER();
    { PHASE_ARGS();
    RUN(8, { pg8::Gemm g{(const bf16*)(ws + Z_V), (const bf16*)(ws + WS_WB), D, D, D, 0}; SO S; S.init(M, D, G, vc);
      Epi<E_YB> E{}; E.O = (bf16*)(ws + WS_MIX); E.Tin = (const bf16*)(ws + WS_T); E.ldc = D; E.Gt = (const bf16*)(ws + Z_G) + 2048;
      pg8::gemm_phase<Epi<E_YB>, SO, true, true>(lds, g, S, E, tid); } )
    }
#endif
    GRID_BAR();
#if PH(6)
    LAUNDER();
    { PHASE_ARGS();
    RUN(9, { pg8::Gemm g{(const bf16*)(ws + WS_MIX), (const bf16*)(ws + WS_WOUT), D, D, D, 0}; SO S; S.init(M, D, G, vc);
      Epi<E_PLAIN> E{}; E.O = (bf16*)(ws + WS_U); E.ldc = D;
      pg8::gemm_phase<Epi<E_PLAIN>, SO, true, true>(lds, g, S, E, tid); } )
    }
#endif
    GRID_BAR();
#if PH(7)
    LAUNDER();
    { PHASE_ARGS();
    RUN(10, res_pass<0>(a.in[0], (const bf16*)(ws + WS_U), a.in[12], a.in[13], a.out, (bf16*)(ws + WS_H2), lane, wave, G); )
    }
#endif
    GRID_BAR();
#if PH(8)
    LAUNDER();
    { PHASE_ARGS();
    RUN(11, { pg8::Gemm g{(const bf16*)(ws + WS_H2), (const bf16*)(ws + WS_WGU), D, D, D, 0}; SO S; S.init(M, NGU, G, vc);
      Epi<E_SWIGLU> E{}; E.O = (bf16*)(ws + WS_F); E.ldc = FF;
      pg8::gemm_phase<Epi<E_SWIGLU>, SO, true, true>(lds, g, S, E, tid); } )
    }
#endif
    GRID_BAR();
#if PH(9)
    LAUNDER();
    { PHASE_ARGS();
    RUN(12, { pg8::Gemm g{(const bf16*)(ws + WS_F), (const bf16*)(ws + WS_WD), FF, FF, FF, 0}; SO S; S.init(M, D, G, vc);
      Epi<E_PLAIN> E{}; E.O = (bf16*)(ws + WS_FO); E.ldc = D;
      pg8::gemm_phase<Epi<E_PLAIN>, SO, true, true>(lds, g, S, E, tid); } )
    }
#endif
    GRID_BAR();
#if PH(10)
    LAUNDER();
    { PHASE_ARGS();
    res_pass<1>(a.out, (const bf16*)(ws + WS_FO), a.in[17], nullptr, a.out, nullptr, lane, wave, G);
    }
#endif
}

extern "C" void kernel_launch(void* const* d_in, const int* in_sizes, int n_in, void* d_out, int out_size, void* d_ws, size_t ws_size, hipStream_t stream) {
    static int grid = 0;
    if (grid == 0) {
        if (n_in != 18 || in_sizes[0] != M * D || out_size != M * D || ws_size < WS_NEED) {
            fprintf(stderr, "kernel_launch: unexpected shapes (n_in %d in0 %d out %d ws %zu need %zu)\n", n_in, n_in > 0 ? in_sizes[0] : -1, out_size, ws_size, (size_t)WS_END); grid = -1; return; }
        int dev = 0, cus = 0, per_cu = 0;
        hipGetDevice(&dev); hipDeviceGetAttribute(&cus, hipDeviceAttributeMultiprocessorCount, dev);
        hipFuncSetAttribute((const void*)fwd_kernel, hipFuncAttributeMaxDynamicSharedMemorySize, LDS_BYTES);
        if (hipOccupancyMaxActiveBlocksPerMultiprocessor(&per_cu, (const void*)fwd_kernel, 512, LDS_BYTES) != hipSuccess || per_cu < 1) per_cu = 1;
        (void)hipGetLastError();
        grid = cus * per_cu;
    }
    if (grid < 0) return;
    (void)hipMemsetAsync((unsigned char*)d_ws + WS_CTL, 0, CTL_BYTES, stream);
    Args a{};
    for (int i = 0; i < 18; ++i) a.in[i] = (const float*)d_in[i];
    a.out = (float*)d_out; a.ws = (unsigned char*)d_ws;
    void* args[] = {&a};
    hipError_t e = hipLaunchCooperativeKernel((const void*)fwd_kernel, dim3(grid), dim3(512), args, LDS_BYTES, stream);
    if (e != hipSuccess) fprintf(stderr, "cooperative launch failed: %s (grid %d)\n", hipGetErrorString(e), grid);
}
```

```cpp
#include <hip/hip_runtime.h>
#include <hip/hip_cooperative_groups.h>
#include <cstdio>
#include <cstdint>
namespace cg = cooperative_groups;

namespace pg8 {
#define PG8_LAS __attribute__((address_space(3)))
typedef unsigned short bf16_t;
typedef short bf16x8 __attribute__((ext_vector_type(8)));
typedef float f32x4 __attribute__((ext_vector_type(4)));
typedef unsigned u32x4 __attribute__((ext_vector_type(4)));
constexpr int BM = 256, BK = 64, HALF = 128, HTB = HALF * BK * 2  , STAGE_BYTES = 8 * HTB, NXCD = 8, WGM = 8;

__host__ __device__ __forceinline__ int lds_byte(int r, int c) { const int st = (r >> 4) * 2 + (c >> 5), rr = r & 15, cc = c & 31, ob = rr * 64 + cc * 2; return st * 1024 + (ob ^ (((ob >> 9) & 1) << 5)); }
__host__ __device__ __forceinline__ void stage_rc(int b, int& R, int& C) { const int st = b / 1024, sb = b % 1024, swz = sb ^ (((sb >> 9) & 1) << 5); R = (st >> 1) * 16 + swz / 64; C = (st & 1) * 32 + (swz % 64) / 2; }
__host__ __device__ __forceinline__ int perm32(int rho) { const int n = rho >> 4, i = rho & 15; return 8 * (i >> 2) + 4 * n + (i & 3); }

struct Unit { int pm, pn; };
struct Gemm { const bf16_t* A; const bf16_t* Bt; int lda, ldb, K; size_t apn; };
struct StaticOrder {
    int nM, nN, nwg, G, c;
    __host__ __device__ void init(int M, int N, int G_, int c_) { nM = M / BM; nN = N / BM; nwg = nM * nN; G = G_; c = c_; }
    __host__ __device__ bool next(int i, Unit& u) const {
        const long L = (long)i * G + c; if (L >= nwg) return false;
        int wgid = (int)L; { const int q = nwg / NXCD, r = nwg % NXCD, xcd = wgid % NXCD, off = wgid / NXCD; wgid = (xcd < r ? xcd * (q + 1) : r * (q + 1) + (xcd - r) * q) + off; }
        const int nig = WGM * nN, gid = wgid / nig, fm = gid * WGM, gsz = (nM - fm) < WGM ? (nM - fm) : WGM;
        u.pm = fm + ((wgid % nig) % gsz); u.pn = (wgid % nig) / gsz; return true;
    }
    __device__ __forceinline__ void a_ready(const Unit&) const {}
    __device__ __forceinline__ void done(const Unit&) const {}
};
__device__ __forceinline__ unsigned cvt_pk_bf16(float lo, float hi) { unsigned r; asm volatile("v_cvt_pk_bf16_f32 %0, %1, %2" : "=v"(r) : "v"(lo), "v"(hi)); return r; }
template <class Epi, class Sched, bool ALIGN_EPI = false, bool SP2 = false>
__device__ __forceinline__ void gemm_phase(PG8_LAS unsigned char* lds, const Gemm g, const Sched& S, const Epi& E, const int tid_in) {
    const int tid = tid_in, wid = __builtin_amdgcn_readfirstlane(tid >> 6), lane = tid & 63, wr = wid >> 2, wc = wid & 3, fr = lane & 15, fq = lane >> 4;
    const int K = g.K, nt = K / BK;
    unsigned voffA[2], voffB[2];
#pragma unroll
    for (int i = 0; i < 2; ++i) { int R, C; stage_rc(tid * 16 + i * 8192, R, C); const int Rb = Epi::PERM ? ((R & ~31) + perm32(R & 31)) : R;
        voffA[i] = (unsigned)(R * g.lda + C) * 2u; voffB[i] = (unsigned)(Rb * g.ldb + C) * 2u; }
    const size_t kstep = (size_t)(BK * 2);
    const size_t hstepA = (size_t)HALF * g.lda * 2, hstepB = (size_t)HALF * g.ldb * 2;
    const size_t tstepA = 2 * hstepA, tstepB = 2 * hstepB;
    const unsigned ldsw = (unsigned)wid * 1024u;
    const int aoff = lds_byte(wr * 64 + fr, fq * 8), boff = lds_byte(wc * 32 + fr, fq * 8);
#define PG8_SA(b, h) (((b) * 2 + (h)) * HTB)
#define PG8_SB(b, h) ((4 + (b) * 2 + (h)) * HTB)
#define PG8_STAGE(bufoff, gbase, voff) do { _Pragma("unroll") for (int _i = 0; _i < 2; ++_i) \
        __builtin_amdgcn_global_load_lds((const unsigned*)((const char*)(gbase) + (voff)[_i]), (PG8_LAS unsigned*)(lds + (bufoff) + ldsw + _i * 8192), 16, 0, 0); } while (0)
#define PG8_LDA(dst, b, h) do { _Pragma("unroll") for (int m = 0; m < 4; ++m) _Pragma("unroll") for (int k = 0; k < 2; ++k) dst[m][k] = *(const PG8_LAS bf16x8*)(lds + PG8_SA(b, h) + aoff + m * 2048 + k * 1024); } while (0)
#define PG8_LDB(dst, b, h) do { _Pragma("unroll") for (int n = 0; n < 2; ++n) _Pragma("unroll") for (int k = 0; k < 2; ++k) dst[n][k] = *(const PG8_LAS bf16x8*)(lds + PG8_SB(b, h) + boff + n * 2048 + k * 1024); } while (0)
#define PG8_MMA(ai, bj, At, Bt) do { __builtin_amdgcn_s_setprio(1); _Pragma("unroll") for (int m = 0; m < 4; ++m) _Pragma("unroll") for (int n = 0; n < 2; ++n) _Pragma("unroll") for (int k = 0; k < 2; ++k) \
        acc[ai][bj][m][n] = __builtin_amdgcn_mfma_f32_16x16x32_bf16(Bt[n][k], At[m][k], acc[ai][bj][m][n], 0, 0, 0); __builtin_amdgcn_s_setprio(0); } while (0)
#define PG8_WAIT_V(n) asm volatile("s_waitcnt vmcnt(" #n ")" ::: "memory")
#define PG8_WAIT_L(n) asm volatile("s_waitcnt lgkmcnt(" #n ")" ::: "memory")
#define PG8_BAR __builtin_amdgcn_s_barrier()
#define PG8_SCHED __builtin_amdgcn_sched_barrier(0)
    Unit cur, nxt; int ui = 0;
    if (!S.next(0, cur)) return;
    f32x4 acc[2][2][4][2];
#pragma unroll
    for (int a = 0; a < 2; ++a)
#pragma unroll
        for (int b = 0; b < 2; ++b)
#pragma unroll
            for (int m = 0; m < 4; ++m)
#pragma unroll
                for (int n = 0; n < 2; ++n) acc[a][b][m][n] = (f32x4){0.f, 0.f, 0.f, 0.f};
    bf16x8 At[4][2], B0[2][2], B1[2][2];
    const char* cA = (const char*)g.A + (size_t)cur.pm * tstepA + (size_t)cur.pn * g.apn; const char* cB = (const char*)g.Bt + (size_t)cur.pn * tstepB;
    S.a_ready(cur);
    if constexpr (SP2) {
        PG8_STAGE(PG8_SB(0, 0), cB, voffB); PG8_STAGE(PG8_SB(0, 1), cB + hstepB, voffB); PG8_STAGE(PG8_SA(0, 0), cA, voffA); PG8_STAGE(PG8_SA(0, 1), cA + hstepA, voffA);
        if (wr == 1) PG8_BAR;
        PG8_WAIT_V(2); PG8_BAR;
        PG8_STAGE(PG8_SB(1, 0), cB + kstep, voffB); PG8_STAGE(PG8_SA(1, 0), cA + kstep, voffA); PG8_STAGE(PG8_SB(1, 1), cB + hstepB + kstep, voffB);
        PG8_WAIT_V(6); PG8_BAR;
    } else {
        PG8_STAGE(PG8_SB(0, 0), cB, voffB); PG8_STAGE(PG8_SA(0, 0), cA, voffA); PG8_STAGE(PG8_SB(0, 1), cB + hstepB, voffB); PG8_STAGE(PG8_SA(0, 1), cA + hstepA, voffA);
        if (wr == 1) PG8_BAR;
        PG8_WAIT_V(4); PG8_BAR;
        PG8_STAGE(PG8_SB(1, 0), cB + kstep, voffB); PG8_STAGE(PG8_SA(1, 0), cA + kstep, voffA); PG8_STAGE(PG8_SB(1, 1), cB + hstepB + kstep, voffB);
        PG8_WAIT_V(6); PG8_BAR;
    }
    for (;;) {
        const bool has_next = S.next(ui + 1, nxt);
        const char* nA = has_next ? (const char*)g.A + (size_t)nxt.pm * tstepA + (size_t)nxt.pn * g.apn : cA; const char* nB = has_next ? (const char*)g.Bt + (size_t)nxt.pn * tstepB : cB;
        for (int t = 0; t < nt; t += 2) {
            const bool last = (t == nt - 2);
            const char* a1 = cA + (size_t)(t + 1) * kstep;
            const char* a2 = last ? nA : cA + (size_t)(t + 2) * kstep; const char* b2 = last ? nB : cB + (size_t)(t + 2) * kstep;
            const char* a3 = a2 + kstep; const char* b3 = b2 + kstep;
            if (last && has_next) S.a_ready(nxt);
            if constexpr (SP2) {
            PG8_LDB(B0, 0, 0); PG8_LDB(B1, 0, 1); PG8_SCHED; PG8_LDA(At, 0, 0); PG8_STAGE(PG8_SA(1, 1), a1 + hstepA, voffA);
            PG8_WAIT_V(8); PG8_WAIT_L(0); PG8_BAR; PG8_MMA(0, 0, At, B0); PG8_MMA(0, 1, At, B1); PG8_BAR; PG8_SCHED;
            PG8_LDA(At, 0, 1); PG8_STAGE(PG8_SB(0, 0), b2, voffB); PG8_STAGE(PG8_SB(0, 1), b2 + hstepB, voffB); PG8_STAGE(PG8_SA(0, 0), a2, voffA);
            PG8_WAIT_V(8); PG8_WAIT_L(0); PG8_BAR; PG8_MMA(1, 0, At, B0); PG8_MMA(1, 1, At, B1); PG8_BAR; PG8_SCHED;
            PG8_LDB(B0, 1, 0); PG8_LDB(B1, 1, 1); PG8_SCHED; PG8_LDA(At, 1, 0); PG8_STAGE(PG8_SA(0, 1), a2 + hstepA, voffA);
            PG8_WAIT_V(8); PG8_WAIT_L(0); PG8_BAR; PG8_MMA(0, 0, At, B0); PG8_MMA(0, 1, At, B1); PG8_BAR; PG8_SCHED;
            PG8_LDA(At, 1, 1); PG8_STAGE(PG8_SB(1, 0), b3, voffB); PG8_STAGE(PG8_SB(1, 1), b3 + hstepB, voffB); PG8_STAGE(PG8_SA(1, 0), a3, voffA);
            PG8_WAIT_V(8); PG8_WAIT_L(0); PG8_BAR; PG8_MMA(1, 0, At, B0); PG8_MMA(1, 1, At, B1); PG8_BAR; PG8_SCHED;
            } else {
            PG8_LDB(B0, 0, 0); PG8_SCHED; PG8_LDA(At, 0, 0); PG8_STAGE(PG8_SA(1, 1), a1 + hstepA, voffA);
            PG8_WAIT_L(8); PG8_BAR; PG8_WAIT_L(0); PG8_MMA(0, 0, At, B0); PG8_BAR; PG8_SCHED;
            PG8_LDB(B1, 0, 1); PG8_STAGE(PG8_SB(0, 0), b2, voffB);
            PG8_BAR; PG8_WAIT_L(0); PG8_MMA(0, 1, At, B1); PG8_BAR;
            PG8_LDA(At, 0, 1); PG8_STAGE(PG8_SA(0, 0), a2, voffA);
            PG8_BAR; PG8_WAIT_L(0); PG8_MMA(1, 0, At, B0); PG8_BAR; PG8_SCHED;
            PG8_STAGE(PG8_SB(0, 1), b2 + hstepB, voffB);
            PG8_WAIT_V(6); PG8_BAR; PG8_MMA(1, 1, At, B1); PG8_BAR;
            PG8_LDB(B0, 1, 0); PG8_SCHED; PG8_LDA(At, 1, 0); PG8_STAGE(PG8_SA(0, 1), a2 + hstepA, voffA);
            PG8_WAIT_L(8); PG8_BAR; PG8_WAIT_L(0); PG8_MMA(0, 0, At, B0); PG8_BAR; PG8_SCHED;
            PG8_LDB(B1, 1, 1); PG8_STAGE(PG8_SB(1, 0), b3, voffB);
            PG8_BAR; PG8_WAIT_L(0); PG8_MMA(0, 1, At, B1); PG8_BAR;
            PG8_LDA(At, 1, 1); PG8_STAGE(PG8_SA(1, 0), a3, voffA);
            PG8_BAR; PG8_WAIT_L(0); PG8_MMA(1, 0, At, B0); PG8_BAR; PG8_SCHED;
            PG8_STAGE(PG8_SB(1, 1), b3 + hstepB, voffB);
            PG8_WAIT_V(6); PG8_BAR; PG8_MMA(1, 1, At, B1); PG8_BAR;
            }
        }
        if constexpr (ALIGN_EPI) { if (wr == 0) PG8_BAR; }
        if constexpr (!Epi::AFTER_DRAIN) { E(acc, cur, wr, wc, fr, fq); S.done(cur); }
        if (!has_next) break;
#pragma unroll
        for (int a = 0; a < 2; ++a)
#pragma unroll
            for (int b = 0; b < 2; ++b)
#pragma unroll
                for (int m = 0; m < 4; ++m)
#pragma unroll
                    for (int n = 0; n < 2; ++n) acc[a][b][m][n] = (f32x4){0.f, 0.f, 0.f, 0.f};
        cur = nxt; cA = nA; cB = nB; ++ui;
        if constexpr (ALIGN_EPI) { if (wr == 1) PG8_BAR; }
    }
    PG8_WAIT_V(0);
    if constexpr (!ALIGN_EPI) { if (wr == 0) PG8_BAR; }
    PG8_BAR;
    if constexpr (Epi::AFTER_DRAIN) { E.fused(acc, cur, wr, wc, fr, fq, lds, wid, lane); S.done(cur); }
#undef PG8_SA
#undef PG8_SB
#undef PG8_STAGE
#undef PG8_LDA
#undef PG8_LDB
#undef PG8_MMA
#undef PG8_WAIT_V
#undef PG8_WAIT_L
#undef PG8_BAR
#undef PG8_SCHED
}
}


#define LAS __attribute__((address_space(3)))
typedef unsigned short bf16;
typedef unsigned v4u __attribute__((ext_vector_type(4)));
typedef unsigned v2u __attribute__((ext_vector_type(2)));
using pg8::f32x4; using pg8::bf16x8; using pg8::Unit;
#define LDS_WAIT() asm volatile("s_waitcnt lgkmcnt(0)" ::: "memory")
#define BAR_LDS() do { asm volatile("s_waitcnt lgkmcnt(0)" ::: "memory"); __builtin_amdgcn_s_barrier(); asm volatile("" ::: "memory"); } while (0)

constexpr int NB = 4, T = 8192, D = 2048, M = NB * T;
constexpr int PW = 1024, KD = 1024, VD = 2048, HK = 256, HV = 512, FF = 5632, DIN = 11280, NZ = 11264, NGU = 11264, NCH = 128;
constexpr float EPS = 1e-6f;
constexpr int LDS_BYTES = 147456;
constexpr size_t MiB = 1u << 20;
constexpr size_t WS_WIN = 0, WS_WGU = 44 * MiB, WS_WD = 88 * MiB, WS_WB = 110 * MiB, WS_WOUT = 118 * MiB, WS_WA = 126 * MiB, WS_WP = 130 * MiB,
                 WS_GLR = 131 * MiB, WS_XN = 133 * MiB, WS_Z = 261 * MiB;
constexpr size_t Z_P = WS_Z, Z_Q = Z_P + 64 * MiB, Z_K = Z_Q + 64 * MiB, Z_V = Z_K + 64 * MiB, Z_R = Z_V + 128 * MiB, Z_G = Z_R + 128 * MiB, WS_END = Z_G + 256 * MiB;
constexpr size_t WS_CTL = WS_END, CTL_BYTES = 32768, CTL_BAR_OFF = 4096, WS_NEED = WS_END + CTL_BYTES;
constexpr int LDS_CTL = 131072 + 1024;
constexpr size_t WS_KDT = WS_XN, WS_QP = WS_XN + 64 * MiB, WS_T = WS_XN, WS_MIX = Z_Q, WS_U = WS_XN, WS_H2 = Z_G, WS_F = WS_Z, WS_FO = WS_Z + 352 * MiB;
constexpr size_t DO_DIFF = 0, DO_AMAT = 64 * MiB, DO_AVEC = 80 * MiB, DO_O = 96 * MiB;

struct Args { const float* in[18]; float* out; unsigned char* ws; };

__device__ __forceinline__ float bflo(unsigned u) { return __uint_as_float(u << 16); }
__device__ __forceinline__ float bfhi(unsigned u) { return __uint_as_float(u & 0xffff0000u); }
typedef float f32x2_t __attribute__((ext_vector_type(2)));
typedef __bf16 bf16x2_t __attribute__((ext_vector_type(2)));
__device__ __forceinline__ unsigned pk_c(float lo, float hi) { f32x2_t v = {lo, hi}; bf16x2_t b = __builtin_convertvector(v, bf16x2_t); return __builtin_bit_cast(unsigned, b); }
__device__ __forceinline__ unsigned pk(float lo, float hi) { return pg8::cvt_pk_bf16(lo, hi); }
__device__ __forceinline__ float sigm(float x) { return __builtin_amdgcn_rcpf(1.f + __expf(-x)); }
__device__ __forceinline__ float silu(float x) { return x * __builtin_amdgcn_rcpf(1.f + __expf(-x)); }
__device__ __forceinline__ float wave_sum(float v) {
#pragma unroll
    for (int o = 1; o < 64; o <<= 1) v += __shfl_xor(v, o);
    return v;
}
__device__ __forceinline__ void unpack8(const v4u u, float (&f)[8]) {
    f[0] = bflo(u.x); f[1] = bfhi(u.x); f[2] = bflo(u.y); f[3] = bfhi(u.y); f[4] = bflo(u.z); f[5] = bfhi(u.z); f[6] = bflo(u.w); f[7] = bfhi(u.w);
}
__device__ __forceinline__ v4u pack8(const float (&f)[8]) { v4u u; u.x = pk(f[0], f[1]); u.y = pk(f[2], f[3]); u.z = pk(f[4], f[5]); u.w = pk(f[6], f[7]); return u; }

enum { E_Z = 0, E_POOL = 1, E_YA = 2, E_YB = 3, E_PLAIN = 4, E_SWIGLU = 5 };
template <int MODE> struct Epi {
    static constexpr bool PERM = true, AFTER_DRAIN = false;
    bf16* O; int ldc;
    const bf16* Gt;
    const bf16* Tin;
    const float* vec;
    bf16 *zP, *zQ, *zK, *zV, *zR, *zG;
    __device__ __forceinline__ void operator()(const f32x4 (&acc)[2][2][4][2], const Unit& u, int wr, int wc, int fr, int fq) const {
        const int row0 = u.pm * 256 + wr * 64 + fr, lc = wc * 32 + 8 * fq;
        if constexpr (MODE == E_SWIGLU) {
#pragma unroll
            for (int ai = 0; ai < 2; ++ai)
#pragma unroll
                for (int m = 0; m < 4; ++m) {
                    const f32x4 g0 = acc[ai][0][m][0], g1 = acc[ai][0][m][1], u0 = acc[ai][1][m][0], u1 = acc[ai][1][m][1];
                    v4u w; w.x = pk(silu(g0[0]) * u0[0], silu(g0[1]) * u0[1]); w.y = pk(silu(g0[2]) * u0[2], silu(g0[3]) * u0[3]);
                    w.z = pk(silu(g1[0]) * u1[0], silu(g1[1]) * u1[1]); w.w = pk(silu(g1[2]) * u1[2], silu(g1[3]) * u1[3]);
                    *(v4u*)(O + (size_t)(row0 + ai * 128 + m * 16) * ldc + u.pn * 128 + lc) = w; }
        } else {
            bf16* base = O; int ld = ldc, ct = u.pn * 256, op = 0;
            if constexpr (MODE == E_Z) {
                const int pn = u.pn;
                if (pn < 4) { base = zP; ld = 1024; ct = pn * 256; }
                else if (pn < 8) { base = zQ; ld = 1024; ct = (pn - 4) * 256; op = 1; }
                else if (pn < 12) { base = zK; ld = 1024; ct = (pn - 8) * 256; }
                else if (pn < 20) { base = zV; ld = 2048; ct = (pn - 12) * 256; }
                else if (pn < 28) { base = zR; ld = 2048; ct = (pn - 20) * 256; op = 2; }
                else { base = zG; ld = 4096; ct = (pn - 28) * 256; op = 3; }
            }
#pragma unroll
            for (int bj = 0; bj < 2; ++bj) {
                const int col = ct + bj * 128 + lc;
                f32x4 s0 = {1.f, 1.f, 1.f, 1.f}, s1 = s0;
                if constexpr (MODE == E_POOL) { s0 = *(const f32x4*)(vec + col); s1 = *(const f32x4*)(vec + col + 4); }
                if constexpr (MODE == E_Z) { if (op == 3) { s0 = *(const f32x4*)(vec + col); s1 = *(const f32x4*)(vec + col + 4); } }
#pragma unroll
                for (int ai = 0; ai < 2; ++ai)
#pragma unroll
                    for (int m = 0; m < 4; ++m) {
                        const size_t row = (size_t)(row0 + ai * 128 + m * 16);
                        f32x4 v0 = acc[ai][bj][m][0], v1 = acc[ai][bj][m][1];
                        if constexpr (MODE == E_POOL) { v0 = v0 * s0; v1 = v1 * s1; }
                        if constexpr (MODE == E_Z) {
                            if (op == 1) { v0 = v0 * 0.0625f; v1 = v1 * 0.0625f; }
                            else if (op == 2) { for (int i = 0; i < 4; ++i) { v0[i] = silu(v0[i]); v1[i] = silu(v1[i]); } }
                            else if (op == 3) { for (int i = 0; i < 4; ++i) { v0[i] = sigm(v0[i] + s0[i]); v1[i] = sigm(v1[i] + s1[i]); } }
                        }
                        if constexpr (MODE == E_YA || MODE == E_YB) {
                            float g[8]; unpack8(*(const v4u*)(Gt + row * 4096 + col), g);
                            for (int i = 0; i < 4; ++i) { v0[i] *= g[i]; v1[i] *= g[4 + i]; }
                            if constexpr (MODE == E_YB) { float t[8]; unpack8(*(const v4u*)(Tin + row * ld + col), t); for (int i = 0; i < 4; ++i) { v0[i] += t[i]; v1[i] += t[4 + i]; } }
                        }
                        v4u w; w.x = pk(v0[0], v0[1]); w.y = pk(v0[2], v0[3]); w.z = pk(v1[0], v1[1]); w.w = pk(v1[2], v1[3]);
                        *(v4u*)(base + row * ld + col) = w; }
            }
        }
    }
};

__device__ __forceinline__ void transpose_item(const float* W, int ldw, int K, int k0, int ns0, bf16* WT, int nd0, LAS float* scr, int lane) {
    float rr[32];
    const float* wp = W + (size_t)(k0 + (lane >> 5)) * ldw + ns0 + (lane & 31);
#pragma unroll
    for (int i = 0; i < 32; ++i) rr[i] = wp[(size_t)(2 * i) * ldw];
#pragma unroll
    for (int i = 0; i < 32; ++i) scr[(2 * i + (lane >> 5)) * 33 + (lane & 31)] = rr[i];
    LDS_WAIT(); asm volatile("" ::: "memory");
    const int c = lane & 7;
#pragma unroll
    for (int j = 0; j < 4; ++j) { const int n = (lane >> 3) + 8 * j; const LAS float* s = scr + (8 * c) * 33 + n;
        v4u o; o.x = pk(s[0 * 33], s[1 * 33]); o.y = pk(s[2 * 33], s[3 * 33]); o.z = pk(s[4 * 33], s[5 * 33]); o.w = pk(s[6 * 33], s[7 * 33]);
        *(v4u*)(WT + (size_t)(nd0 + n) * K + k0 + 8 * c) = o; }
    LDS_WAIT(); asm volatile("" ::: "memory");
}

__device__ __forceinline__ void phase0(const Args& a, LAS unsigned char* lds, int tid, int lane, int wave, int G) {
    unsigned char* ws = a.ws;
    LAS float* scr = (LAS float*)(lds + wave * 16384);
    const int gw = blockIdx.x * 8 + wave, NGW = G * 8;
    constexpr int I_IN = 32 * 352, I_GU = 32 * 176, I_D = 88 * 64, I_SQ = 32 * 64, I_A = 16 * 64, I_P = 4 * 4 * 8;
    constexpr int NITEMS = I_IN + 2 * I_GU + I_D + 2 * I_SQ + I_A + I_P;
    for (int it = gw; it < NITEMS; it += NGW) {
        int r = it;
        if (r < I_IN) { const int kb = r / 352, nb = r % 352, nd0 = 32 * nb, ns0 = nd0 < 5120 ? nd0 : nd0 + 16;
            transpose_item(a.in[2], DIN, D, 64 * kb, ns0, (bf16*)(ws + WS_WIN), nd0, scr, lane); continue; } r -= I_IN;
        if (r < I_GU) { const int kb = r / 176, nb = r % 176, c = 32 * nb, nd0 = (c >> 7) * 256 + (c & 127);
            transpose_item(a.in[14], FF, D, 64 * kb, c, (bf16*)(ws + WS_WGU), nd0, scr, lane); continue; } r -= I_GU;
        if (r < I_GU) { const int kb = r / 176, nb = r % 176, c = 32 * nb, nd0 = (c >> 7) * 256 + (c & 127) + 128;
            transpose_item(a.in[15], FF, D, 64 * kb, c, (bf16*)(ws + WS_WGU), nd0, scr, lane); continue; } r -= I_GU;
        if (r < I_D) { const int kb = r / 64, nb = r % 64;
            transpose_item(a.in[16], D, FF, 64 * kb, 32 * nb, (bf16*)(ws + WS_WD), 32 * nb, scr, lane); continue; } r -= I_D;
        if (r < I_SQ) { const int kb = r / 64, nb = r % 64;
            transpose_item(a.in[9], D, D, 64 * kb, 32 * nb, (bf16*)(ws + WS_WB), 32 * nb, scr, lane); continue; } r -= I_SQ;
        if (r < I_SQ) { const int kb = r / 64, nb = r % 64;
            transpose_item(a.in[11], D, D, 64 * kb, 32 * nb, (bf16*)(ws + WS_WOUT), 32 * nb, scr, lane); continue; } r -= I_SQ;
        if (r < I_A) { const int kb = r / 64, nb = r % 64;
            transpose_item(a.in[8], D, PW, 64 * kb, 32 * nb, (bf16*)(ws + WS_WA), 32 * nb, scr, lane); continue; } r -= I_A;
        { const int g = r / 32, rr = r % 32, kb = rr / 8, nb = rr % 8;
            transpose_item(a.in[5] + (size_t)g * 65536, 256, 256, 64 * kb, 32 * nb, (bf16*)(ws + WS_WP) + (size_t)g * 65536, 32 * nb, scr, lane); }
    }
    __syncthreads();
    LAS float* wgt = (LAS float*)lds;
    for (int e = tid; e < 2048 * 4; e += 512) { const int k = e >> 2, q4 = e & 3; const f32x4 v = *(const f32x4*)(a.in[2] + (size_t)k * DIN + 5120 + 4 * q4);
        wgt[(4 * q4 + 0) * 2048 + k] = v[0]; wgt[(4 * q4 + 1) * 2048 + k] = v[1]; wgt[(4 * q4 + 2) * 2048 + k] = v[2]; wgt[(4 * q4 + 3) * 2048 + k] = v[3]; }
    __syncthreads();
    f32x4 gn[8];
#pragma unroll
    for (int j = 0; j < 8; ++j) gn[j] = *(const f32x4*)(a.in[1] + 256 * j + 4 * lane);
    bf16* XN = (bf16*)(ws + WS_XN); float* glr = (float*)(ws + WS_GLR);
    typedef float f32x2 __attribute__((ext_vector_type(2)));
    f32x4 na[8], nb[8];
    if (gw < M / 2) {
#pragma unroll
        for (int j = 0; j < 8; ++j) { na[j] = *(const f32x4*)(a.in[0] + (size_t)(2 * gw) * D + 256 * j + 4 * lane); nb[j] = *(const f32x4*)(a.in[0] + (size_t)(2 * gw + 1) * D + 256 * j + 4 * lane); }
    }
    const int hi = lane >> 5;
    for (int pr = gw; pr < M / 2; pr += NGW) {
        const size_t ra = 2 * (size_t)pr, rb = ra + 1;
        f32x2 xab[8][4]; float ssa = 0.f, ssb = 0.f;
#pragma unroll
        for (int j = 0; j < 8; ++j) {
            const f32x4 va = na[j], vb = nb[j];
            ssa += (va[0] * va[0] + va[1] * va[1]) + (va[2] * va[2] + va[3] * va[3]); ssb += (vb[0] * vb[0] + vb[1] * vb[1]) + (vb[2] * vb[2] + vb[3] * vb[3]);
#pragma unroll
            for (int i = 0; i < 4; ++i) xab[j][i] = (f32x2){va[i] * gn[j][i], vb[i] * gn[j][i]}; }
        { const int nx = (pr + NGW < M / 2) ? pr + NGW : pr;
#pragma unroll
          for (int j = 0; j < 8; ++j) { na[j] = *(const f32x4*)(a.in[0] + (size_t)(2 * nx) * D + 256 * j + 4 * lane); nb[j] = *(const f32x4*)(a.in[0] + (size_t)(2 * nx + 1) * D + 256 * j + 4 * lane); } }
        const float rsa = rsqrtf(wave_sum(ssa) * (1.f / D) + EPS), rsb = rsqrtf(wave_sum(ssb) * (1.f / D) + EPS);
#pragma unroll
        for (int j = 0; j < 8; ++j) { v2u wa, wb; wa.x = pk(xab[j][0].x * rsa, xab[j][1].x * rsa); wa.y = pk(xab[j][2].x * rsa, xab[j][3].x * rsa); wb.x = pk(xab[j][0].y * rsb, xab[j][1].y * rsb); wb.y = pk(xab[j][2].y * rsb, xab[j][3].y * rsb);
            *(v2u*)(XN + ra * D + 256 * j + 4 * lane) = wa; *(v2u*)(XN + rb * D + 256 * j + 4 * lane) = wb; }
        float v[16];
#pragma unroll
        for (int jj = 0; jj < 16; ++jj) { f32x2 s0 = {0.f, 0.f}, s1 = {0.f, 0.f};
#pragma unroll
            for (int j = 0; j < 8; ++j) { const f32x4 w = *(const LAS f32x4*)(wgt + jj * 2048 + 256 * j + 4 * lane);
                s0 = xab[j][0] * w[0] + s0; s1 = xab[j][1] * w[1] + s1; s0 = xab[j][2] * w[2] + s0; s1 = xab[j][3] * w[3] + s1; }
            s0 = s0 + s1;
            const float mine = hi ? s0.y : s0.x, send = hi ? s0.x : s0.y;
            v[jj] = mine + __shfl_xor(send, 32); }
#pragma unroll
        for (int st = 0; st < 4; ++st) { const int n = 8 >> st, msk = 16 >> st; const bool b = (lane & msk) != 0;
#pragma unroll
            for (int i = 0; i < n; ++i) { const float mine = b ? v[i + n] : v[i], send = b ? v[i] : v[i + n]; v[i] = mine + __shfl_xor(send, msk); } }
        v[0] += __shfl_xor(v[0], 1);
        if ((lane & 1) == 0) glr[(ra + hi) * 16 + ((lane >> 1) & 15)] = v[0] * (hi ? rsb : rsa);
    }
}

template <int W> __device__ __forceinline__ void pool_block(const bf16* P, bf16* Dd, int tblk, int c8) {
    const int t0 = tblk * 8, pos0 = t0 & (T - 1);
    constexpr int R = W + 7;
    v4u rows[R];
#pragma unroll
    for (int r = 0; r < R; ++r) { const int dt = r - (W - 1); const bool valid = (pos0 + dt) >= 0;
        rows[r] = valid ? *(const v4u*)(P + (size_t)(t0 + dt) * 1024 + c8 * 8) : (v4u){0u, 0u, 0u, 0u}; }
    float s[8];
#pragma unroll
    for (int i = 0; i < 8; ++i) s[i] = 0.f;
#pragma unroll
    for (int r = 0; r < W - 1; ++r) { float f[8]; unpack8(rows[r], f);
#pragma unroll
        for (int i = 0; i < 8; ++i) s[i] += f[i]; }
#pragma unroll
    for (int o = 0; o < 8; ++o) {
        float cur[8]; unpack8(rows[o + W - 1], cur);
#pragma unroll
        for (int i = 0; i < 8; ++i) s[i] += cur[i];
        const int cnt = (pos0 + o + 1 < W) ? pos0 + o + 1 : W; const float inv = __builtin_amdgcn_rcpf((float)cnt);
        float d[8];
#pragma unroll
        for (int i = 0; i < 8; ++i) d[i] = s[i] * inv - cur[i];
        *(v4u*)(Dd + (size_t)(t0 + o) * 1024 + c8 * 8) = pack8(d);
        float old[8]; unpack8(rows[o], old);
#pragma unroll
        for (int i = 0; i < 8; ++i) s[i] -= old[i];
    }
}
__device__ __forceinline__ void pool_diff(const bf16* P, bf16* Dd, int lane, int wave, int G) {
    const int gw = blockIdx.x * 8 + wave, NGW = G * 8;
    for (int wi = gw; wi < 4 * (M / 16); wi += NGW) {
        const int g = (wi + (wi >> 11)) & 3, tp = wi >> 2, tblk = 2 * tp + (lane >> 5), c8 = g * 32 + (lane & 31);
        if (g == 0) pool_block<2>(P, Dd, tblk, c8); else if (g == 1) pool_block<4>(P, Dd, tblk, c8); else if (g == 2) pool_block<8>(P, Dd, tblk, c8); else pool_block<16>(P, Dd, tblk, c8);
    }
}

__device__ __forceinline__ void gla_prepass(const Args& a, LAS unsigned char* lds, int tid, int lane, int wave, int G) {
    unsigned char* ws = a.ws;
    constexpr int QS = 0, KS = 33792, WU = 67584;
    const bf16* Q = (const bf16*)(ws + Z_Q); bf16* Qp = (bf16*)(ws + WS_QP); const bf16* Kb = (const bf16*)(ws + Z_K); bf16* KdT = (bf16*)(ws + WS_KDT);
    bf16* Amat = (bf16*)((unsigned char*)a.out + DO_AMAT); float* avec = (float*)((unsigned char*)a.out + DO_AVEC);
    const float* glr = (const float*)(ws + WS_GLR);
    const int l15 = lane & 15, g4 = lane >> 4;
    for (int it = blockIdx.x; it < 2048; it += G) {
        const int bh = it >> 7, c = it & 127, b = bh >> 2, h = bh & 3; const size_t t0 = (size_t)b * T + (size_t)c * 64;
        const size_t trow = t0 + lane; const int kc0 = h * 256 + 32 * wave;
        f32x4 gl[4];
#pragma unroll
        for (int i = 0; i < 4; ++i) gl[i] = *(const f32x4*)(glr + trow * 16 + 4 * i);
        v4u qv[4], kv[4];
#pragma unroll
        for (int i = 0; i < 4; ++i) { qv[i] = *(const v4u*)(Q + trow * 1024 + kc0 + 8 * i); kv[i] = *(const v4u*)(Kb + trow * 1024 + kc0 + 8 * i); }
        for (int e = tid; e < 17 * 64; e += 512) { const int jr = e >> 6, c4 = (e & 63) * 4;
            const f32x4 v = (jr < 16) ? *(const f32x4*)(a.in[3] + jr * 1024 + h * 256 + c4) : *(const f32x4*)(a.in[4] + h * 256 + c4);
            *(LAS f32x4*)(lds + WU + (jr * 256 + c4) * 4) = v; }
        __syncthreads();
        float Gc[32];
#pragma unroll
        for (int q8 = 0; q8 < 8; ++q8) {
            f32x4 z = *(const LAS f32x4*)(lds + WU + (16 * 256 + 32 * wave + 4 * q8) * 4);
#pragma unroll
            for (int jr = 0; jr < 16; ++jr) { const f32x4 w = *(const LAS f32x4*)(lds + WU + (jr * 256 + 32 * wave + 4 * q8) * 4); z = z + w * gl[jr >> 2][jr & 3]; }
#pragma unroll
            for (int i = 0; i < 4; ++i) { const float zz = z[i]; Gc[4 * q8 + i] = (fminf(zz, 0.f) - __logf(1.f + __expf(-fabsf(zz)))) * 0.0625f; }
        }
#pragma unroll
        for (int d = 1; d < 64; d <<= 1) {
#pragma unroll
            for (int cc = 0; cc < 32; ++cc) { const float up = __shfl_up(Gc[cc], d); Gc[cc] += (lane >= d) ? up : 0.f; } }
        float kd[32]; unsigned qpk[16], kpk[16];
#pragma unroll
        for (int i = 0; i < 4; ++i) { float qf[8], kf[8]; unpack8(qv[i], qf); unpack8(kv[i], kf);
#pragma unroll
            for (int e = 0; e < 8; ++e) { const int cc = 8 * i + e; const float Gv = Gc[cc], Gl = __shfl(Gv, 63);
                const float eg = __expf(Gv), ie = __expf(-Gv);
                qf[e] = qf[e] * eg; kd[cc] = kf[e] * __expf(Gl - Gv); kf[e] = kf[e] * ie;
                if (lane == 63) Gc[cc] = eg; }
            const v4u qo = pack8(qf), ko = pack8(kf);
            *(v4u*)(Qp + trow * 1024 + kc0 + 8 * i) = qo;
            *(LAS v4u*)(lds + QS + lane * 528 + (32 * wave + 8 * i) * 2) = qo; *(LAS v4u*)(lds + KS + lane * 528 + (32 * wave + 8 * i) * 2) = ko; }
        if (lane == 63) {
#pragma unroll
            for (int i = 0; i < 8; ++i) *(f32x4*)(avec + (size_t)it * 256 + 32 * wave + 4 * i) = (f32x4){Gc[4 * i], Gc[4 * i + 1], Gc[4 * i + 2], Gc[4 * i + 3]}; }
#pragma unroll
        for (int cc = 0; cc < 32; cc += 2) { const unsigned p2 = pk(kd[cc], kd[cc + 1]);
            KdT[((size_t)it * 256 + 32 * wave + cc) * 64 + lane] = (unsigned short)(p2 & 0xffffu); KdT[((size_t)it * 256 + 32 * wave + cc + 1) * 64 + lane] = (unsigned short)(p2 >> 16); }
        __syncthreads();
        const int jt = wave >> 1, it0 = 2 * (wave & 1);
        f32x4 c0 = {0.f, 0.f, 0.f, 0.f}, c1 = c0;
#pragma unroll
        for (int kk = 0; kk < 8; ++kk) {
            const bf16x8 av = *(const LAS bf16x8*)(lds + KS + (16 * jt + l15) * 528 + (32 * kk + 8 * g4) * 2);
            const bf16x8 b0 = *(const LAS bf16x8*)(lds + QS + (16 * it0 + l15) * 528 + (32 * kk + 8 * g4) * 2);
            const bf16x8 b1 = *(const LAS bf16x8*)(lds + QS + (16 * it0 + 16 + l15) * 528 + (32 * kk + 8 * g4) * 2);
            c0 = __builtin_amdgcn_mfma_f32_16x16x32_bf16(av, b0, c0, 0, 0, 0); c1 = __builtin_amdgcn_mfma_f32_16x16x32_bf16(av, b1, c1, 0, 0, 0); }
        { const int jb = 16 * jt + 4 * g4; const int i0 = 16 * it0 + l15, i1 = i0 + 16;
          v2u w0, w1;
          w0.x = pk(jb + 0 <= i0 ? c0[0] : 0.f, jb + 1 <= i0 ? c0[1] : 0.f); w0.y = pk(jb + 2 <= i0 ? c0[2] : 0.f, jb + 3 <= i0 ? c0[3] : 0.f);
          w1.x = pk(jb + 0 <= i1 ? c1[0] : 0.f, jb + 1 <= i1 ? c1[1] : 0.f); w1.y = pk(jb + 2 <= i1 ? c1[2] : 0.f, jb + 3 <= i1 ? c1[3] : 0.f);
          *(v2u*)(Amat + (size_t)it * 4096 + i0 * 64 + jb) = w0; *(v2u*)(Amat + (size_t)it * 4096 + i1 * 64 + jb) = w1; }
        __syncthreads();
    }
}

__device__ __forceinline__ void gla_seq(const Args& a, LAS unsigned char* lds, int tid, int lane, int wave, int G, int vc) {
    unsigned char* ws = a.ws;
    constexpr int QS = 0, KT = 33792, AS = 70656, VT = 79872, ST = 84480, AV = 101376;
    const bf16* Q = (const bf16*)(ws + WS_QP); const bf16* KdT = (const bf16*)(ws + WS_KDT); const bf16* V = (const bf16*)(ws + Z_V); bf16* Ob = (bf16*)((unsigned char*)a.out + DO_O);
    const bf16* Amat = (const bf16*)((unsigned char*)a.out + DO_AMAT); const float* avec = (const float*)((unsigned char*)a.out + DO_AVEC);
    const int l15 = lane & 15, g4 = lane >> 4;
    for (int it = vc; it < 256; it += G) {
        const int vi = (it & 7) * 32 + (it >> 3), bh = vi >> 4, vs = vi & 15, b = bh >> 2, h = bh & 3;
        const size_t tb = (size_t)b * T;
        const bf16* qbase = Q + tb * 1024 + h * 256;
        const bf16* ktbase = KdT + (size_t)bh * 128 * 16384;
        const bf16* abase = Amat + (size_t)bh * 128 * 4096;
        const float* avbase = avec + (size_t)bh * 128 * 256;
        const bf16* vbase = V + tb * 2048 + h * 512 + vs * 32; bf16* obase = Ob + tb * 2048 + h * 512 + vs * 32;
        for (int e = tid; e < 16896 / 4; e += 512) ((LAS unsigned*)(lds + ST))[e] = 0u;
        f32x4 sacc[2][2];
#pragma unroll
        for (int i = 0; i < 2; ++i)
#pragma unroll
            for (int j = 0; j < 2; ++j) sacc[i][j] = (f32x4){0.f, 0.f, 0.f, 0.f};
        v4u rq0[4], rk0[4], ra0, rq1[4], rk1[4], ra1; v2u rv0, rv1; f32x4 rav0 = {0.f, 0.f, 0.f, 0.f}, rav1 = rav0;
#define GLA_LOAD(cc, S) do { \
        _Pragma("unroll") for (int r = 0; r < 4; ++r) { const int e = tid + 512 * r; rq##S[r] = *(const v4u*)(qbase + (size_t)((cc) * 64 + (e >> 5)) * 1024 + (e & 31) * 8); } \
        _Pragma("unroll") for (int r = 0; r < 4; ++r) rk##S[r] = *(const v4u*)(ktbase + (size_t)(cc) * 16384 + (size_t)(tid + 512 * r) * 8); \
        ra##S = *(const v4u*)(abase + (size_t)(cc) * 4096 + tid * 8); \
        rv##S = *(const v2u*)(vbase + (size_t)((cc) * 64 + (tid >> 3)) * 2048 + (tid & 7) * 4); \
        rav##S = *(const f32x4*)(avbase + (cc) * 256 + (tid & 63) * 4); } while (0)
#define GLA_STEP(c, S) do { \
            _Pragma("unroll") for (int r = 0; r < 4; ++r) { const int e = tid + 512 * r; *(LAS v4u*)(lds + QS + (e >> 5) * 528 + (e & 31) * 16) = rq##S[r]; *(LAS v4u*)(lds + KT + (e >> 3) * 144 + (e & 7) * 16) = rk##S[r]; } \
            *(LAS v4u*)(lds + AS + (tid >> 3) * 144 + (tid & 7) * 16) = ra##S; \
            { LAS unsigned short* vt = (LAS unsigned short*)(lds + VT); const int j = tid >> 3, n0 = 4 * (tid & 7); \
              vt[(n0 + 0) * 72 + j] = (unsigned short)(rv##S.x & 0xffffu); vt[(n0 + 1) * 72 + j] = (unsigned short)(rv##S.x >> 16); \
              vt[(n0 + 2) * 72 + j] = (unsigned short)(rv##S.y & 0xffffu); vt[(n0 + 3) * 72 + j] = (unsigned short)(rv##S.y >> 16); } \
            if (tid < 64) *(LAS f32x4*)(lds + AV + tid * 16) = rav##S; \
            BAR_LDS(); \
            GLA_LOAD(((c) + 2 < NCH ? (c) + 2 : NCH - 1), S); \
            { const int nt = wave & 1, itl = wave >> 1; \
              f32x4 oa = {0.f, 0.f, 0.f, 0.f}, ob = oa; \
              _Pragma("unroll") for (int kk = 0; kk < 8; kk += 2) { \
                  const bf16x8 a0 = *(const LAS bf16x8*)(lds + ST + (16 * nt + l15) * 528 + (32 * kk + 8 * g4) * 2), b0 = *(const LAS bf16x8*)(lds + QS + (16 * itl + l15) * 528 + (32 * kk + 8 * g4) * 2); \
                  const bf16x8 a1 = *(const LAS bf16x8*)(lds + ST + (16 * nt + l15) * 528 + (32 * kk + 32 + 8 * g4) * 2), b1 = *(const LAS bf16x8*)(lds + QS + (16 * itl + l15) * 528 + (32 * kk + 32 + 8 * g4) * 2); \
                  oa = __builtin_amdgcn_mfma_f32_16x16x32_bf16(a0, b0, oa, 0, 0, 0); ob = __builtin_amdgcn_mfma_f32_16x16x32_bf16(a1, b1, ob, 0, 0, 0); } \
              { const bf16x8 a0 = *(const LAS bf16x8*)(lds + VT + (16 * nt + l15) * 144 + (8 * g4) * 2), b0 = *(const LAS bf16x8*)(lds + AS + (16 * itl + l15) * 144 + (8 * g4) * 2); \
                const bf16x8 a1 = *(const LAS bf16x8*)(lds + VT + (16 * nt + l15) * 144 + (32 + 8 * g4) * 2), b1 = *(const LAS bf16x8*)(lds + AS + (16 * itl + l15) * 144 + (32 + 8 * g4) * 2); \
                oa = __builtin_amdgcn_mfma_f32_16x16x32_bf16(a0, b0, oa, 0, 0, 0); ob = __builtin_amdgcn_mfma_f32_16x16x32_bf16(a1, b1, ob, 0, 0, 0); } \
              oa = oa + ob; \
              v2u w; w.x = pk_c(oa[0], oa[1]); w.y = pk_c(oa[2], oa[3]); \
              *(v2u*)(obase + (size_t)((c) * 64 + 16 * itl + l15) * 2048 + 16 * nt + 4 * g4) = w; } \
            asm volatile("" ::: "memory"); \
            _Pragma("unroll") for (int kt = 0; kt < 2; ++kt) { \
                const f32x4 dec = *(const LAS f32x4*)(lds + AV + (32 * wave + 16 * kt + 4 * g4) * 4); \
                const bf16x8 ka0 = *(const LAS bf16x8*)(lds + KT + (32 * wave + 16 * kt + l15) * 144 + (8 * g4) * 2), ka1 = *(const LAS bf16x8*)(lds + KT + (32 * wave + 16 * kt + l15) * 144 + (32 + 8 * g4) * 2); \
                _Pragma("unroll") for (int nt = 0; nt < 2; ++nt) { \
                    const bf16x8 vb0 = *(const LAS bf16x8*)(lds + VT + (16 * nt + l15) * 144 + (8 * g4) * 2), vb1 = *(const LAS bf16x8*)(lds + VT + (16 * nt + l15) * 144 + (32 + 8 * g4) * 2); \
                    f32x4 sv = sacc[kt][nt] * dec; \
                    sv = __builtin_amdgcn_mfma_f32_16x16x32_bf16(ka0, vb0, sv, 0, 0, 0); sv = __builtin_amdgcn_mfma_f32_16x16x32_bf16(ka1, vb1, sv, 0, 0, 0); \
                    sacc[kt][nt] = sv; } } \
            BAR_LDS(); \
            _Pragma("unroll") for (int kt = 0; kt < 2; ++kt) \
                _Pragma("unroll") for (int nt = 0; nt < 2; ++nt) { const f32x4 sv = sacc[kt][nt]; v2u w; w.x = pk_c(sv[0], sv[1]); w.y = pk_c(sv[2], sv[3]); \
                    *(LAS v2u*)(lds + ST + (16 * nt + l15) * 528 + (32 * wave + 16 * kt + 4 * g4) * 2) = w; } \
        } while (0)
        GLA_LOAD(0, 0); GLA_LOAD(1, 1);
        for (int c = 0; c < NCH; c += 2) { GLA_STEP(c, 0); GLA_STEP(c + 1, 1); }
#undef GLA_LOAD
#undef GLA_STEP
        __syncthreads();
    }
}

__device__ __forceinline__ void on_pass(const Args& a, int lane, int wave, int G) {
    const bf16* O = (const bf16*)((unsigned char*)a.out + DO_O); bf16* ON = (bf16*)(a.ws + Z_V); const bf16* R = (const bf16*)(a.ws + Z_R);
    const f32x4 gA = *(const f32x4*)(a.in[7] + 8 * lane), gB = *(const f32x4*)(a.in[7] + 8 * lane + 4);
    const int gw = blockIdx.x * 8 + wave, NGW = G * 8;
    v4u ov[4], rv[4];
    if (gw < M) {
#pragma unroll
        for (int j = 0; j < 4; ++j) { ov[j] = *(const v4u*)(O + (size_t)gw * 2048 + 8 * lane + 512 * j); rv[j] = *(const v4u*)(R + (size_t)gw * 2048 + 8 * lane + 512 * j); }
    }
    for (int row = gw; row < M; row += NGW) {
        bf16* on = ON + (size_t)row * 2048 + 8 * lane;
        v4u oc[4], rc[4];
#pragma unroll
        for (int j = 0; j < 4; ++j) { oc[j] = ov[j]; rc[j] = rv[j]; }
        { const int nx = (row + NGW < M) ? row + NGW : row;
#pragma unroll
          for (int j = 0; j < 4; ++j) { ov[j] = *(const v4u*)(O + (size_t)nx * 2048 + 8 * lane + 512 * j); rv[j] = *(const v4u*)(R + (size_t)nx * 2048 + 8 * lane + 512 * j); } }
#pragma unroll
        for (int j = 0; j < 4; ++j) { float f[8], s[8]; unpack8(oc[j], f); unpack8(rc[j], s); float ss = 0.f;
#pragma unroll
            for (int i = 0; i < 8; ++i) ss += f[i] * f[i];
            const float rs = rsqrtf(wave_sum(ss) * (1.f / 512.f) + EPS);
#pragma unroll
            for (int i = 0; i < 4; ++i) { f[i] = f[i] * rs * gA[i] * s[i]; f[4 + i] = f[4 + i] * rs * gB[i] * s[4 + i]; }
            *(v4u*)(on + 512 * j) = pack8(f); }
    }
}
template <int MODE> __device__ __forceinline__ void res_pass(const float* xin, const bf16* U, const float* g1p, const float* g2p, float* out, bf16* H2, int lane, int wave, int G) {
    f32x4 g1[4][2], g2[4][2];
#pragma unroll
    for (int j = 0; j < 4; ++j)
#pragma unroll
        for (int q = 0; q < 2; ++q) { g1[j][q] = *(const f32x4*)(g1p + 512 * j + 8 * lane + 4 * q); if (MODE == 0) g2[j][q] = *(const f32x4*)(g2p + 512 * j + 8 * lane + 4 * q); }
    const int gw = blockIdx.x * 8 + wave, NGW = G * 8;
    for (int row = gw; row < M; row += NGW) {
        const size_t ro = (size_t)row * 2048 + 8 * lane;
        v4u uv[4]; f32x4 xv[4][2];
#pragma unroll
        for (int j = 0; j < 4; ++j) { uv[j] = *(const v4u*)(U + ro + 512 * j); xv[j][0] = *(const f32x4*)(xin + ro + 512 * j); xv[j][1] = *(const f32x4*)(xin + ro + 512 * j + 4); }
        float uf[4][8]; float ss = 0.f;
#pragma unroll
        for (int j = 0; j < 4; ++j) { unpack8(uv[j], uf[j]);
#pragma unroll
            for (int i = 0; i < 8; ++i) ss += uf[j][i] * uf[j][i]; }
        const float rs = rsqrtf(wave_sum(ss) * (1.f / 2048.f) + EPS);
        float s1 = 0.f;
#pragma unroll
        for (int j = 0; j < 4; ++j)
#pragma unroll
            for (int q = 0; q < 2; ++q)
#pragma unroll
                for (int i = 0; i < 4; ++i) { const float v = xv[j][q][i] + uf[j][4 * q + i] * rs * g1[j][q][i]; xv[j][q][i] = v; s1 += v * v; }
#pragma unroll
        for (int j = 0; j < 4; ++j) { *(f32x4*)(out + ro + 512 * j) = xv[j][0]; *(f32x4*)(out + ro + 512 * j + 4) = xv[j][1]; }
        if (MODE == 0) {
            const float r1 = rsqrtf(wave_sum(s1) * (1.f / 2048.f) + EPS);
#pragma unroll
            for (int j = 0; j < 4; ++j) { float f[8];
#pragma unroll
                for (int i = 0; i < 4; ++i) { f[i] = xv[j][0][i] * r1 * g2[j][0][i]; f[4 + i] = xv[j][1][i] * r1 * g2[j][1][i]; }
                *(v4u*)(H2 + ro + 512 * j) = pack8(f); }
        }
    }
}

#define XB_TMO      128
#define XB_XCNT(j)  (256  + 64 * (j))
#define XB_XSUB(j)  (1280 + 64 * (j))
#define XB_XGEN(j)  (2304 + 64 * (j))
#define XB_TOP      3328
#define XB_TOPGEN   3392
#define XCD_BAR_WORDS 3456
#define XB_SPIN_CAP (1u << 18)

__device__ __forceinline__ unsigned xb_ld(unsigned* p)              { return __hip_atomic_load(p, __ATOMIC_RELAXED, __HIP_MEMORY_SCOPE_AGENT); }
__device__ __forceinline__ unsigned xb_add(unsigned* p, unsigned v) { return __hip_atomic_fetch_add(p, v, __ATOMIC_RELAXED, __HIP_MEMORY_SCOPE_AGENT); }
__device__ __forceinline__ unsigned xb_xcc_id() { return (unsigned)__builtin_amdgcn_s_getreg((3 << 11) | 20) & 0xFu; }
#define XB_SPIN(cond, bar) do { unsigned _sp = 0; while (cond) { __builtin_amdgcn_s_sleep(1); \
    if ((++_sp & 255u) == 0u) { if (xb_ld(&(bar)[XB_TMO])) break; if (_sp > XB_SPIN_CAP) { atomicAdd(&(bar)[XB_TMO], 1u); break; } } } } while (0)

struct XcdBarrier {
    unsigned* bar; unsigned x;
    volatile LAS unsigned* st;
};

__device__ __forceinline__ void xcd_barrier_post(unsigned* bar, bool t0) {
    if (t0) (void)xb_add(&bar[XB_XCNT(xb_xcc_id())], 1u);
}
__device__ __forceinline__ void xcd_barrier_complete(unsigned* bar, unsigned x, unsigned& nloc, unsigned& nx) {
    const unsigned G = gridDim.x * gridDim.y * gridDim.z;
    unsigned sum, cnt, mine, sp = 0u;
    for (;;) {
        sum = 0u; cnt = 0u; mine = 0u;
#pragma unroll
        for (unsigned j = 0; j < 16; ++j) { const unsigned c = xb_ld(&bar[XB_XCNT(j)]); sum += c; cnt += (c > 0u) ? 1u : 0u; mine = (j == x) ? c : mine; }
        if (sum == G) break;
        __builtin_amdgcn_s_sleep(1);
        if ((++sp & 255u) == 0u) { if (xb_ld(&bar[XB_TMO])) break; if (sp > XB_SPIN_CAP) { atomicAdd(&bar[XB_TMO], 1u); break; } }
    }
    nloc = mine > 0u ? mine : 1u; nx = cnt > 0u ? cnt : 1u;
}

__device__ __forceinline__ void xcd_barrier(const XcdBarrier& b, const bool t0) {
    asm volatile("s_waitcnt vmcnt(0)" ::: "memory");
    __syncthreads();
    if (t0) {
        unsigned* bar = b.bar;
        __builtin_amdgcn_s_waitcnt(0);
        unsigned nloc = b.st[0], nx = b.st[1];
        if (nloc == 0u) { xcd_barrier_complete(bar, b.x, nloc, nx); b.st[0] = nloc; b.st[1] = nx; }
        const unsigned old = xb_add(&bar[XB_XSUB(b.x)], 1u);
        const unsigned gen = old / nloc;
        if (old + 1u == (gen + 1u) * nloc) {
            __builtin_amdgcn_fence(__ATOMIC_RELEASE, "agent");
            asm volatile("s_waitcnt vmcnt(0)" ::: "memory");
            const unsigned og = xb_add(&bar[XB_TOP], 1u);
            const unsigned tg = og / nx;
            if (og + 1u == (tg + 1u) * nx) xb_add(&bar[XB_TOPGEN], 1u);
            else XB_SPIN(xb_ld(&bar[XB_TOPGEN]) == tg, bar);
            __builtin_amdgcn_fence(__ATOMIC_ACQUIRE, "agent");
            xb_add(&bar[XB_XGEN(b.x)], 1u);
            asm volatile("s_waitcnt vmcnt(0)" ::: "memory");
        } else {
            XB_SPIN(xb_ld(&bar[XB_XGEN(b.x)]) == gen, bar);
            __builtin_amdgcn_fence(__ATOMIC_ACQUIRE, "agent");
            asm volatile("s_waitcnt vmcnt(0)" ::: "memory");
        }
    }
    __syncthreads();
}

#ifndef PH_MASK
#define PH_MASK 0xffff
#endif
#define PH(n) ((PH_MASK >> (n)) & 1)
#ifndef DBL_MASK
#define DBL_MASK 0x0
#endif
#define REP(k) (((DBL_MASK >> (k)) & 1) ? 2 : 1)
#define RUN(k, ...) for (int rep_ = 0; rep_ < REP(k); ++rep_) { if (rep_) { __syncthreads(); grid.sync(); } __VA_ARGS__ }
typedef const __attribute__((address_space(4))) Args* ArgsP;
__device__ __forceinline__ ArgsP get_args() { ArgsP p = (ArgsP)__builtin_amdgcn_kernarg_segment_ptr(); asm volatile("" : "+s"(p)); return p; }
__global__ void __launch_bounds__(512, 2) fwd_kernel(Args a_unused) {
    extern __shared__ __attribute__((aligned(16))) unsigned char lds_raw[];
    LAS unsigned char* lds = (LAS unsigned char*)lds_raw;
    cg::grid_group grid = cg::this_grid();
    const int wave_s = __builtin_amdgcn_readfirstlane(threadIdx.x >> 6); int tid, lane, wave; const int G = gridDim.x;
#define LAUNDER() do { unsigned m_ = ~0u; int w_ = wave_s; asm volatile("" : "+s"(m_), "+s"(w_)); lane = (int)__builtin_amdgcn_mbcnt_hi(m_, __builtin_amdgcn_mbcnt_lo(m_, 0u)); wave = w_; tid = (wave << 6) | lane; } while (0)
    { ArgsP ap0 = get_args(); unsigned* ctl = (unsigned*)(ap0->ws + WS_CTL);
      if (threadIdx.x == 0) { const unsigned xcc = (unsigned)__builtin_amdgcn_s_getreg((3 << 11) | 20) & 0xFu; const unsigned rank = atomicAdd(ctl + 64 * (xcc & 7u), 1u);
          volatile LAS unsigned* lc = (volatile LAS unsigned*)(lds + LDS_CTL); lc[0] = xcc; lc[1] = rank; lc[2] = blockIdx.x; lc[8] = 0u; lc[9] = 0u; }
      xcd_barrier_post((unsigned*)(ap0->ws + WS_CTL + CTL_BAR_OFF), threadIdx.x == 0); }
#define GRID_BAR() do { XcdBarrier xb_; xb_.bar = (unsigned*)(get_args()->ws + WS_CTL + CTL_BAR_OFF); xb_.x = xb_xcc_id(); xb_.st = (volatile LAS unsigned*)(lds + LDS_CTL) + 8; xcd_barrier(xb_, wave_s == 0 && __builtin_amdgcn_mbcnt_hi(~0u, __builtin_amdgcn_mbcnt_lo(~0u, 0u)) == 0u); } while (0)
#define PHASE_ARGS() ArgsP ap_ = get_args(); Args a; _Pragma("unroll") for (int i_ = 0; i_ < 18; ++i_) a.in[i_] = ap_->in[i_]; a.out = ap_->out; a.ws = ap_->ws; unsigned char* const ws = a.ws; (void)ws; const int vc = __builtin_amdgcn_readfirstlane((int)((volatile LAS unsigned*)(lds + LDS_CTL))[2]); (void)vc
    typedef pg8::StaticOrder SO;
#if PH(0)
    LAUNDER();
    { PHASE_ARGS();
    RUN(0, phase0(a, lds, tid, lane, wave, G); )
    }
#endif
    grid.sync();
    { ArgsP ap0 = get_args(); unsigned* ctl = (unsigned*)(ap0->ws + WS_CTL);
      if (threadIdx.x == 0) { volatile LAS unsigned* lc = (volatile LAS unsigned*)(lds + LDS_CTL); bool ok = (G % 8) == 0;
          for (int x = 0; x < 8; ++x) ok = ok && (__hip_atomic_load(ctl + 64 * x, __ATOMIC_RELAXED, __HIP_MEMORY_SCOPE_AGENT) == (unsigned)(G / 8));
          const unsigned xcc = lc[0], rank = lc[1]; lc[2] = (ok && xcc < 8u) ? xcc + 8u * rank : blockIdx.x; }
      __syncthreads(); }
#if PH(1)
    LAUNDER();
    { PHASE_ARGS();
    RUN(1, { pg8::Gemm g{(const bf16*)(ws + WS_XN), (const bf16*)(ws + WS_WIN), D, D, D, 0}; SO S; S.init(M, NZ, G, vc);
      Epi<E_Z> E{}; E.vec = a.in[10]; E.zP = (bf16*)(ws + Z_P); E.zQ = (bf16*)(ws + Z_Q); E.zK = (bf16*)(ws + Z_K); E.zV = (bf16*)(ws + Z_V); E.zR = (bf16*)(ws + Z_R); E.zG = (bf16*)(ws + Z_G);
      pg8::gemm_phase<Epi<E_Z>, SO, true, true>(lds, g, S, E, tid); } )
    }
#endif
    GRID_BAR();
#if PH(2)
    LAUNDER();
    { PHASE_ARGS();
    RUN(2, pool_diff((const bf16*)(ws + Z_P), (bf16*)((unsigned char*)a.out + DO_DIFF), lane, wave, G); )
    RUN(3, gla_prepass(a, lds, tid, lane, wave, G); )
    }
#endif
    GRID_BAR();
#if PH(3)
    LAUNDER();
    { PHASE_ARGS();
    RUN(4, gla_seq(a, lds, tid, lane, wave, G, vc); )
    RUN(5, { pg8::Gemm g{(const bf16*)((unsigned char*)a.out + DO_DIFF), (const bf16*)(ws + WS_WP), PW, 256, 256, 512}; SO S; S.init(M, PW, G, vc);
      Epi<E_POOL> E{}; E.O = (bf16*)(ws + Z_P); E.ldc = PW; E.vec = a.in[6];
      pg8::gemm_phase<Epi<E_POOL>, SO, true, true>(lds, g, S, E, tid); } )
    }
#endif
    GRID_BAR();
#if PH(4)
    LAUNDER();
    { PHASE_ARGS();
    RUN(6, on_pass(a, lane, wave, G); )
    RUN(7, { pg8::Gemm g{(const bf16*)(ws + Z_P), (const bf16*)(ws + WS_WA), PW, PW, PW, 0}; SO S; S.init(M, D, G, vc);
      Epi<E_YA> E{}; E.O = (bf16*)(ws + WS_T); E.ldc = D; E.Gt = (const bf16*)(ws + Z_G);
      pg8::gemm_phase<Epi<E_YA>, SO, true, true>(lds, g, S, E, tid); } )
    }
#endif
    GRID_BAR();
#if PH(5)
    LAUNDER();
    { PHASE_ARGS();
    RUN(8, { pg8::Gemm g{(const bf16*)(ws + Z_V), (const bf16*)(ws + WS_WB), D, D, D, 0}; SO S; S.init(M, D, G, vc);
      Epi<E_YB> E{}; E.O = (bf16*)(ws + WS_MIX); E.Tin = (const bf16*)(ws + WS_T); E.ldc = D; E.Gt = (const bf16*)(ws + Z_G) + 2048;
      pg8::gemm_phase<Epi<E_YB>, SO, true, true>(lds, g, S, E, tid); } )
    }
#endif
    GRID_BAR();
#if PH(6)
    LAUNDER();
    { PHASE_ARGS();
    RUN(9, { pg8::Gemm g{(const bf16*)(ws + WS_MIX), (const bf16*)(ws + WS_WOUT), D, D, D, 0}; SO S; S.init(M, D, G, vc);
      Epi<E_PLAIN> E{}; E.O = (bf16*)(ws + WS_U); E.ldc = D;
      pg8::gemm_phase<Epi<E_PLAIN>, SO, true, true>(lds, g, S, E, tid); } )
    }
#endif
    GRID_BAR();
#if PH(7)
    LAUNDER();
    { PHASE_ARGS();
    RUN(10, res_pass<0>(a.in[0], (const bf16*)(ws + WS_U), a.in[12], a.in[13], a.out, (bf16*)(ws + WS_H2), lane, wave, G); )
    }
#endif
    GRID_BAR();
#if PH(8)
    LAUNDER();
    { PHASE_ARGS();
    RUN(11, { pg8::Gemm g{(const bf16*)(ws + WS_H2), (const bf16*)(ws + WS_WGU), D, D, D, 0}; SO S; S.init(M, NGU, G, vc);
      Epi<E_SWIGLU> E{}; E.O = (bf16*)(ws + WS_F); E.ldc = FF;
      pg8::gemm_phase<Epi<E_SWIGLU>, SO, true, true>(lds, g, S, E, tid); } )
    }
#endif
    GRID_BAR();
#if PH(9)
    LAUNDER();
    { PHASE_ARGS();
    RUN(12, { pg8::Gemm g{(const bf16*)(ws + WS_F), (const bf16*)(ws + WS_WD), FF, FF, FF, 0}; SO S; S.init(M, D, G, vc);
      Epi<E_PLAIN> E{}; E.O = (bf16*)(ws + WS_FO); E.ldc = D;
      pg8::gemm_phase<Epi<E_PLAIN>, SO, true, true>(lds, g, S, E, tid); } )
    }
#endif
    GRID_BAR();
#if PH(10)
    LAUNDER();
    { PHASE_ARGS();
    res_pass<1>(a.out, (const bf16*)(ws + WS_FO), a.in[17], nullptr, a.out, nullptr, lane, wave, G);
    }
#endif
}

extern "C" void kernel_launch(void* const* d_in, const int* in_sizes, int n_in, void* d_out, int out_size, void* d_ws, size_t ws_size, hipStream_t stream) {
    static int grid = 0;
    if (grid == 0) {
        if (n_in != 18 || in_sizes[0] != M * D || out_size != M * D || ws_size < WS_NEED) {
            fprintf(stderr, "kernel_launch: unexpected shapes (n_in %d in0 %d out %d ws %zu need %zu)\n", n_in, n_in > 0 ? in_sizes[0] : -1, out_size, ws_size, (size_t)WS_END); grid = -1; return; }
        int dev = 0, cus = 0, per_cu = 0;
        hipGetDevice(&dev); hipDeviceGetAttribute(&cus, hipDeviceAttributeMultiprocessorCount, dev);
        hipFuncSetAttribute((const void*)fwd_kernel, hipFuncAttributeMaxDynamicSharedMemorySize, LDS_BYTES);
        if (hipOccupancyMaxActiveBlocksPerMultiprocessor(&per_cu, (const void*)fwd_kernel, 512, LDS_BYTES) != hipSuccess || per_cu < 1) per_cu = 1;
        (void)hipGetLastError();
        grid = cus * per_cu;
    }
    if (grid < 0) return;
    (void)hipMemsetAsync((unsigned char*)d_ws + WS_CTL, 0, CTL_BYTES, stream);
    Args a{};
    for (int i = 0; i < 18; ++i) a.in[i] = (const float*)d_in[i];
    a.out = (float*)d_out; a.ws = (unsigned char*)d_ws;
    void* args[] = {&a};
    hipError_t e = hipLaunchCooperativeKernel((const void*)fwd_kernel, dim3(grid), dim3(512), args, LDS_BYTES, stream);
    if (e != hipSuccess) fprintf(stderr, "cooperative launch failed: %s (grid %d)\n", hipGetErrorString(e), grid);
}
```

```cpp
#include <hip/hip_runtime.h>
#include <hip/hip_cooperative_groups.h>
#include <cstdio>
#include <cstdint>
namespace cg = cooperative_groups;

namespace pg8 {
#define PG8_LAS __attribute__((address_space(3)))
typedef unsigned short bf16_t;
typedef short bf16x8 __attribute__((ext_vector_type(8)));
typedef float f32x4 __attribute__((ext_vector_type(4)));
typedef unsigned u32x4 __attribute__((ext_vector_type(4)));
constexpr int BM = 256, BK = 64, HALF = 128, HTB = HALF * BK * 2  , STAGE_BYTES = 8 * HTB, NXCD = 8, WGM = 8;

__host__ __device__ __forceinline__ int lds_byte(int r, int c) { const int st = (r >> 4) * 2 + (c >> 5), rr = r & 15, cc = c & 31, ob = rr * 64 + cc * 2; return st * 1024 + (ob ^ (((ob >> 9) & 1) << 5)); }
__host__ __device__ __forceinline__ void stage_rc(int b, int& R, int& C) { const int st = b / 1024, sb = b % 1024, swz = sb ^ (((sb >> 9) & 1) << 5); R = (st >> 1) * 16 + swz / 64; C = (st & 1) * 32 + (swz % 64) / 2; }
__host__ __device__ __forceinline__ int perm32(int rho) { const int n = rho >> 4, i = rho & 15; return 8 * (i >> 2) + 4 * n + (i & 3); }

struct Unit { int pm, pn; };
struct Gemm { const bf16_t* A; const bf16_t* Bt; int lda, ldb, K; size_t apn; };
struct StaticOrder {
    int nM, nN, nwg, G, c;
    __host__ __device__ void init(int M, int N, int G_, int c_) { nM = M / BM; nN = N / BM; nwg = nM * nN; G = G_; c = c_; }
    __host__ __device__ bool next(int i, Unit& u) const {
        const long L = (long)i * G + c; if (L >= nwg) return false;
        int wgid = (int)L; { const int q = nwg / NXCD, r = nwg % NXCD, xcd = wgid % NXCD, off = wgid / NXCD; wgid = (xcd < r ? xcd * (q + 1) : r * (q + 1) + (xcd - r) * q) + off; }
        const int nig = WGM * nN, gid = wgid / nig, fm = gid * WGM, gsz = (nM - fm) < WGM ? (nM - fm) : WGM;
        u.pm = fm + ((wgid % nig) % gsz); u.pn = (wgid % nig) / gsz; return true;
    }
    __device__ __forceinline__ void a_ready(const Unit&) const {}
    __device__ __forceinline__ void done(const Unit&) const {}
};
__device__ __forceinline__ unsigned cvt_pk_bf16(float lo, float hi) { unsigned r; asm volatile("v_cvt_pk_bf16_f32 %0, %1, %2" : "=v"(r) : "v"(lo), "v"(hi)); return r; }
template <class Epi, class Sched, bool ALIGN_EPI = false, bool SP2 = false>
__device__ __forceinline__ void gemm_phase(PG8_LAS unsigned char* lds, const Gemm g, const Sched& S, const Epi& E, const int tid_in) {
    const int tid = tid_in, wid = __builtin_amdgcn_readfirstlane(tid >> 6), lane = tid & 63, wr = wid >> 2, wc = wid & 3, fr = lane & 15, fq = lane >> 4;
    const int K = g.K, nt = K / BK;
    unsigned voffA[2], voffB[2];
#pragma unroll
    for (int i = 0; i < 2; ++i) { int R, C; stage_rc(tid * 16 + i * 8192, R, C); const int Rb = Epi::PERM ? ((R & ~31) + perm32(R & 31)) : R;
        voffA[i] = (unsigned)(R * g.lda + C) * 2u; voffB[i] = (unsigned)(Rb * g.ldb + C) * 2u; }
    const size_t kstep = (size_t)(BK * 2);
    const size_t hstepA = (size_t)HALF * g.lda * 2, hstepB = (size_t)HALF * g.ldb * 2;
    const size_t tstepA = 2 * hstepA, tstepB = 2 * hstepB;
    const unsigned ldsw = (unsigned)wid * 1024u;
    const int aoff = lds_byte(wr * 64 + fr, fq * 8), boff = lds_byte(wc * 32 + fr, fq * 8);
#define PG8_SA(b, h) (((b) * 2 + (h)) * HTB)
#define PG8_SB(b, h) ((4 + (b) * 2 + (h)) * HTB)
#define PG8_STAGE(bufoff, gbase, voff) do { _Pragma("unroll") for (int _i = 0; _i < 2; ++_i) \
        __builtin_amdgcn_global_load_lds((const unsigned*)((const char*)(gbase) + (voff)[_i]), (PG8_LAS unsigned*)(lds + (bufoff) + ldsw + _i * 8192), 16, 0, 0); } while (0)
#define PG8_LDA(dst, b, h) do { _Pragma("unroll") for (int m = 0; m < 4; ++m) _Pragma("unroll") for (int k = 0; k < 2; ++k) dst[m][k] = *(const PG8_LAS bf16x8*)(lds + PG8_SA(b, h) + aoff + m * 2048 + k * 1024); } while (0)
#define PG8_LDB(dst, b, h) do { _Pragma("unroll") for (int n = 0; n < 2; ++n) _Pragma("unroll") for (int k = 0; k < 2; ++k) dst[n][k] = *(const PG8_LAS bf16x8*)(lds + PG8_SB(b, h) + boff + n * 2048 + k * 1024); } while (0)
#define PG8_MMA(ai, bj, At, Bt) do { __builtin_amdgcn_s_setprio(1); _Pragma("unroll") for (int m = 0; m < 4; ++m) _Pragma("unroll") for (int n = 0; n < 2; ++n) _Pragma("unroll") for (int k = 0; k < 2; ++k) \
        acc[ai][bj][m][n] = __builtin_amdgcn_mfma_f32_16x16x32_bf16(Bt[n][k], At[m][k], acc[ai][bj][m][n], 0, 0, 0); __builtin_amdgcn_s_setprio(0); } while (0)
#define PG8_WAIT_V(n) asm volatile("s_waitcnt vmcnt(" #n ")" ::: "memory")
#define PG8_WAIT_L(n) asm volatile("s_waitcnt lgkmcnt(" #n ")" ::: "memory")
#define PG8_BAR __builtin_amdgcn_s_barrier()
#define PG8_SCHED __builtin_amdgcn_sched_barrier(0)
    Unit cur, nxt; int ui = 0;
    if (!S.next(0, cur)) return;
    f32x4 acc[2][2][4][2];
#pragma unroll
    for (int a = 0; a < 2; ++a)
#pragma unroll
        for (int b = 0; b < 2; ++b)
#pragma unroll
            for (int m = 0; m < 4; ++m)
#pragma unroll
                for (int n = 0; n < 2; ++n) acc[a][b][m][n] = (f32x4){0.f, 0.f, 0.f, 0.f};
    bf16x8 At[4][2], B0[2][2], B1[2][2];
    const char* cA = (const char*)g.A + (size_t)cur.pm * tstepA + (size_t)cur.pn * g.apn; const char* cB = (const char*)g.Bt + (size_t)cur.pn * tstepB;
    S.a_ready(cur);
    if constexpr (SP2) {
        PG8_STAGE(PG8_SB(0, 0), cB, voffB); PG8_STAGE(PG8_SB(0, 1), cB + hstepB, voffB); PG8_STAGE(PG8_SA(0, 0), cA, voffA); PG8_STAGE(PG8_SA(0, 1), cA + hstepA, voffA);
        if (wr == 1) PG8_BAR;
        PG8_WAIT_V(2); PG8_BAR;
        PG8_STAGE(PG8_SB(1, 0), cB + kstep, voffB); PG8_STAGE(PG8_SA(1, 0), cA + kstep, voffA); PG8_STAGE(PG8_SB(1, 1), cB + hstepB + kstep, voffB);
        PG8_WAIT_V(6); PG8_BAR;
    } else {
        PG8_STAGE(PG8_SB(0, 0), cB, voffB); PG8_STAGE(PG8_SA(0, 0), cA, voffA); PG8_STAGE(PG8_SB(0, 1), cB + hstepB, voffB); PG8_STAGE(PG8_SA(0, 1), cA + hstepA, voffA);
        if (wr == 1) PG8_BAR;
        PG8_WAIT_V(4); PG8_BAR;
        PG8_STAGE(PG8_SB(1, 0), cB + kstep, voffB); PG8_STAGE(PG8_SA(1, 0), cA + kstep, voffA); PG8_STAGE(PG8_SB(1, 1), cB + hstepB + kstep, voffB);
        PG8_WAIT_V(6); PG8_BAR;
    }
    for (;;) {
        const bool has_next = S.next(ui + 1, nxt);
        const char* nA = has_next ? (const char*)g.A + (size_t)nxt.pm * tstepA + (size_t)nxt.pn * g.apn : cA; const char* nB = has_next ? (const char*)g.Bt + (size_t)nxt.pn * tstepB : cB;
        for (int t = 0; t < nt; t += 2) {
            const bool last = (t == nt - 2);
            const char* a1 = cA + (size_t)(t + 1) * kstep;
            const char* a2 = last ? nA : cA + (size_t)(t + 2) * kstep; const char* b2 = last ? nB : cB + (size_t)(t + 2) * kstep;
            const char* a3 = a2 + kstep; const char* b3 = b2 + kstep;
            if (last && has_next) S.a_ready(nxt);
            if constexpr (SP2) {
            PG8_LDB(B0, 0, 0); PG8_LDB(B1, 0, 1); PG8_SCHED; PG8_LDA(At, 0, 0); PG8_STAGE(PG8_SA(1, 1), a1 + hstepA, voffA);
            PG8_WAIT_V(8); PG8_WAIT_L(0); PG8_BAR; PG8_MMA(0, 0, At, B0); PG8_MMA(0, 1, At, B1); PG8_BAR; PG8_SCHED;
            PG8_LDA(At, 0, 1); PG8_STAGE(PG8_SB(0, 0), b2, voffB); PG8_STAGE(PG8_SB(0, 1), b2 + hstepB, voffB); PG8_STAGE(PG8_SA(0, 0), a2, voffA);
            PG8_WAIT_V(8); PG8_WAIT_L(0); PG8_BAR; PG8_MMA(1, 0, At, B0); PG8_MMA(1, 1, At, B1); PG8_BAR; PG8_SCHED;
            PG8_LDB(B0, 1, 0); PG8_LDB(B1, 1, 1); PG8_SCHED; PG8_LDA(At, 1, 0); PG8_STAGE(PG8_SA(0, 1), a2 + hstepA, voffA);
            PG8_WAIT_V(8); PG8_WAIT_L(0); PG8_BAR; PG8_MMA(0, 0, At, B0); PG8_MMA(0, 1, At, B1); PG8_BAR; PG8_SCHED;
            PG8_LDA(At, 1, 1); PG8_STAGE(PG8_SB(1, 0), b3, voffB); PG8_STAGE(PG8_SB(1, 1), b3 + hstepB, voffB); PG8_STAGE(PG8_SA(1, 0), a3, voffA);
            PG8_WAIT_V(8); PG8_WAIT_L(0); PG8_BAR; PG8_MMA(1, 0, At, B0); PG8_MMA(1, 1, At, B1); PG8_BAR; PG8_SCHED;
            } else {
            PG8_LDB(B0, 0, 0); PG8_SCHED; PG8_LDA(At, 0, 0); PG8_STAGE(PG8_SA(1, 1), a1 + hstepA, voffA);
            PG8_WAIT_L(8); PG8_BAR; PG8_WAIT_L(0); PG8_MMA(0, 0, At, B0); PG8_BAR; PG8_SCHED;
            PG8_LDB(B1, 0, 1); PG8_STAGE(PG8_SB(0, 0), b2, voffB);
            PG8_BAR; PG8_WAIT_L(0); PG8_MMA(0, 1, At, B1); PG8_BAR;
            PG8_LDA(At, 0, 1); PG8_STAGE(PG8_SA(0, 0), a2, voffA);
            PG8_BAR; PG8_WAIT_L(0); PG8_MMA(1, 0, At, B0); PG8_BAR; PG8_SCHED;
            PG8_STAGE(PG8_SB(0, 1), b2 + hstepB, voffB);
            PG8_WAIT_V(6); PG8_BAR; PG8_MMA(1, 1, At, B1); PG8_BAR;
            PG8_LDB(B0, 1, 0); PG8_SCHED; PG8_LDA(At, 1, 0); PG8_STAGE(PG8_SA(0, 1), a2 + hstepA, voffA);
            PG8_WAIT_L(8); PG8_BAR; PG8_WAIT_L(0); PG8_MMA(0, 0, At, B0); PG8_BAR; PG8_SCHED;
            PG8_LDB(B1, 1, 1); PG8_STAGE(PG8_SB(1, 0), b3, voffB);
            PG8_BAR; PG8_WAIT_L(0); PG8_MMA(0, 1, At, B1); PG8_BAR;
            PG8_LDA(At, 1, 1); PG8_STAGE(PG8_SA(1, 0), a3, voffA);
            PG8_BAR; PG8_WAIT_L(0); PG8_MMA(1, 0, At, B0); PG8_BAR; PG8_SCHED;
            PG8_STAGE(PG8_SB(1, 1), b3 + hstepB, voffB);
            PG8_WAIT_V(6); PG8_BAR; PG8_MMA(1, 1, At, B1); PG8_BAR;
            }
        }
        if constexpr (ALIGN_EPI) { if (wr == 0) PG8_BAR; }
        if constexpr (!Epi::AFTER_DRAIN) { E(acc, cur, wr, wc, fr, fq); S.done(cur); }
        if (!has_next) break;
#pragma unroll
        for (int a = 0; a < 2; ++a)
#pragma unroll
            for (int b = 0; b < 2; ++b)
#pragma unroll
                for (int m = 0; m < 4; ++m)
#pragma unroll
                    for (int n = 0; n < 2; ++n) acc[a][b][m][n] = (f32x4){0.f, 0.f, 0.f, 0.f};
        cur = nxt; cA = nA; cB = nB; ++ui;
        if constexpr (ALIGN_EPI) { if (wr == 1) PG8_BAR; }
    }
    PG8_WAIT_V(0);
    if constexpr (!ALIGN_EPI) { if (wr == 0) PG8_BAR; }
    PG8_BAR;
    if constexpr (Epi::AFTER_DRAIN) { E.fused(acc, cur, wr, wc, fr, fq, lds, wid, lane); S.done(cur); }
#undef PG8_SA
#undef PG8_SB
#undef PG8_STAGE
#undef PG8_LDA
#undef PG8_LDB
#undef PG8_MMA
#undef PG8_WAIT_V
#undef PG8_WAIT_L
#undef PG8_BAR
#undef PG8_SCHED
}
}


#define LAS __attribute__((address_space(3)))
typedef unsigned short bf16;
typedef unsigned v4u __attribute__((ext_vector_type(4)));
typedef unsigned v2u __attribute__((ext_vector_type(2)));
using pg8::f32x4; using pg8::bf16x8; using pg8::Unit;
#define LDS_WAIT() asm volatile("s_waitcnt lgkmcnt(0)" ::: "memory")
#define BAR_LDS() do { asm volatile("s_waitcnt lgkmcnt(0)" ::: "memory"); __builtin_amdgcn_s_barrier(); asm volatile("" ::: "memory"); } while (0)

constexpr int NB = 4, T = 8192, D = 2048, M = NB * T;
constexpr int PW = 1024, KD = 1024, VD = 2048, HK = 256, HV = 512, FF = 5632, DIN = 11280, NZ = 11264, NGU = 11264, NCH = 128;
constexpr float EPS = 1e-6f;
constexpr int LDS_BYTES = 147456;
constexpr size_t MiB = 1u << 20;
constexpr size_t WS_WIN = 0, WS_WGU = 44 * MiB, WS_WD = 88 * MiB, WS_WB = 110 * MiB, WS_WOUT = 118 * MiB, WS_WA = 126 * MiB, WS_WP = 130 * MiB,
                 WS_GLR = 131 * MiB, WS_XN = 133 * MiB, WS_Z = 261 * MiB;
constexpr size_t Z_P = WS_Z, Z_Q = Z_P + 64 * MiB, Z_K = Z_Q + 64 * MiB, Z_V = Z_K + 64 * MiB, Z_R = Z_V + 128 * MiB, Z_G = Z_R + 128 * MiB, WS_END = Z_G + 256 * MiB;
constexpr size_t WS_CTL = WS_END, CTL_BYTES = 32768, CTL_BAR_OFF = 4096, WS_NEED = WS_END + CTL_BYTES;
constexpr int LDS_CTL = 131072 + 1024;
constexpr size_t WS_KDT = WS_XN, WS_QP = WS_XN + 64 * MiB, WS_T = WS_XN, WS_MIX = Z_Q, WS_U = WS_XN, WS_H2 = Z_G, WS_F = WS_Z, WS_FO = WS_Z + 352 * MiB;
constexpr size_t DO_DIFF = 0, DO_AMAT = 64 * MiB, DO_AVEC = 80 * MiB, DO_O = 96 * MiB;

struct Args { const float* in[18]; float* out; unsigned char* ws; };

__device__ __forceinline__ float bflo(unsigned u) { return __uint_as_float(u << 16); }
__device__ __forceinline__ float bfhi(unsigned u) { return __uint_as_float(u & 0xffff0000u); }
typedef float f32x2_t __attribute__((ext_vector_type(2)));
typedef __bf16 bf16x2_t __attribute__((ext_vector_type(2)));
__device__ __forceinline__ unsigned pk_c(float lo, float hi) { f32x2_t v = {lo, hi}; bf16x2_t b = __builtin_convertvector(v, bf16x2_t); return __builtin_bit_cast(unsigned, b); }
__device__ __forceinline__ unsigned pk(float lo, float hi) { return pg8::cvt_pk_bf16(lo, hi); }
__device__ __forceinline__ float sigm(float x) { return __builtin_amdgcn_rcpf(1.f + __expf(-x)); }
__device__ __forceinline__ float silu(float x) { return x * __builtin_amdgcn_rcpf(1.f + __expf(-x)); }
__device__ __forceinline__ float wave_sum(float v) {
#pragma unroll
    for (int o = 1; o < 64; o <<= 1) v += __shfl_xor(v, o);
    return v;
}
__device__ __forceinline__ void unpack8(const v4u u, float (&f)[8]) {
    f[0] = bflo(u.x); f[1] = bfhi(u.x); f[2] = bflo(u.y); f[3] = bfhi(u.y); f[4] = bflo(u.z); f[5] = bfhi(u.z); f[6] = bflo(u.w); f[7] = bfhi(u.w);
}
__device__ __forceinline__ v4u pack8(const float (&f)[8]) { v4u u; u.x = pk(f[0], f[1]); u.y = pk(f[2], f[3]); u.z = pk(f[4], f[5]); u.w = pk(f[6], f[7]); return u; }

enum { E_Z = 0, E_POOL = 1, E_YA = 2, E_YB = 3, E_PLAIN = 4, E_SWIGLU = 5 };
template <int MODE> struct Epi {
    static constexpr bool PERM = true, AFTER_DRAIN = false;
    bf16* O; int ldc;
    const bf16* Gt;
    const bf16* Tin;
    const float* vec;
    bf16 *zP, *zQ, *zK, *zV, *zR, *zG;
    __device__ __forceinline__ void operator()(const f32x4 (&acc)[2][2][4][2], const Unit& u, int wr, int wc, int fr, int fq) const {
        const int row0 = u.pm * 256 + wr * 64 + fr, lc = wc * 32 + 8 * fq;
        if constexpr (MODE == E_SWIGLU) {
#pragma unroll
            for (int ai = 0; ai < 2; ++ai)
#pragma unroll
                for (int m = 0; m < 4; ++m) {
                    const f32x4 g0 = acc[ai][0][m][0], g1 = acc[ai][0][m][1], u0 = acc[ai][1][m][0], u1 = acc[ai][1][m][1];
                    v4u w; w.x = pk(silu(g0[0]) * u0[0], silu(g0[1]) * u0[1]); w.y = pk(silu(g0[2]) * u0[2], silu(g0[3]) * u0[3]);
                    w.z = pk(silu(g1[0]) * u1[0], silu(g1[1]) * u1[1]); w.w = pk(silu(g1[2]) * u1[2], silu(g1[3]) * u1[3]);
                    *(v4u*)(O + (size_t)(row0 + ai * 128 + m * 16) * ldc + u.pn * 128 + lc) = w; }
        } else {
            bf16* base = O; int ld = ldc, ct = u.pn * 256, op = 0;
            if constexpr (MODE == E_Z) {
                const int pn = u.pn;
                if (pn < 4) { base = zP; ld = 1024; ct = pn * 256; }
                else if (pn < 8) { base = zQ; ld = 1024; ct = (pn - 4) * 256; op = 1; }
                else if (pn < 12) { base = zK; ld = 1024; ct = (pn - 8) * 256; }
                else if (pn < 20) { base = zV; ld = 2048; ct = (pn - 12) * 256; }
                else if (pn < 28) { base = zR; ld = 2048; ct = (pn - 20) * 256; op = 2; }
                else { base = zG; ld = 4096; ct = (pn - 28) * 256; op = 3; }
            }
#pragma unroll
            for (int bj = 0; bj < 2; ++bj) {
                const int col = ct + bj * 128 + lc;
                f32x4 s0 = {1.f, 1.f, 1.f, 1.f}, s1 = s0;
                if constexpr (MODE == E_POOL) { s0 = *(const f32x4*)(vec + col); s1 = *(const f32x4*)(vec + col + 4); }
                if constexpr (MODE == E_Z) { if (op == 3) { s0 = *(const f32x4*)(vec + col); s1 = *(const f32x4*)(vec + col + 4); } }
#pragma unroll
                for (int ai = 0; ai < 2; ++ai)
#pragma unroll
                    for (int m = 0; m < 4; ++m) {
                        const size_t row = (size_t)(row0 + ai * 128 + m * 16);
                        f32x4 v0 = acc[ai][bj][m][0], v1 = acc[ai][bj][m][1];
                        if constexpr (MODE == E_POOL) { v0 = v0 * s0; v1 = v1 * s1; }
                        if constexpr (MODE == E_Z) {
                            if (op == 1) { v0 = v0 * 0.0625f; v1 = v1 * 0.0625f; }
                            else if (op == 2) { for (int i = 0; i < 4; ++i) { v0[i] = silu(v0[i]); v1[i] = silu(v1[i]); } }
                            else if (op == 3) { for (int i = 0; i < 4; ++i) { v0[i] = sigm(v0[i] + s0[i]); v1[i] = sigm(v1[i] + s1[i]); } }
                        }
                        if constexpr (MODE == E_YA || MODE == E_YB) {
                            float g[8]; unpack8(*(const v4u*)(Gt + row * 4096 + col), g);
                            for (int i = 0; i < 4; ++i) { v0[i] *= g[i]; v1[i] *= g[4 + i]; }
                            if constexpr (MODE == E_YB) { float t[8]; unpack8(*(const v4u*)(Tin + row * ld + col), t); for (int i = 0; i < 4; ++i) { v0[i] += t[i]; v1[i] += t[4 + i]; } }
                        }
                        v4u w; w.x = pk(v0[0], v0[1]); w.y = pk(v0[2], v0[3]); w.z = pk(v1[0], v1[1]); w.w = pk(v1[2], v1[3]);
                        *(v4u*)(base + row * ld + col) = w; }
            }
        }
    }
};

__device__ __forceinline__ void transpose_item(const float* W, int ldw, int K, int k0, int ns0, bf16* WT, int nd0, LAS float* scr, int lane) {
    float rr[32];
    const float* wp = W + (size_t)(k0 + (lane >> 5)) * ldw + ns0 + (lane & 31);
#pragma unroll
    for (int i = 0; i < 32; ++i) rr[i] = wp[(size_t)(2 * i) * ldw];
#pragma unroll
    for (int i = 0; i < 32; ++i) scr[(2 * i + (lane >> 5)) * 33 + (lane & 31)] = rr[i];
    LDS_WAIT(); asm volatile("" ::: "memory");
    const int c = lane & 7;
#pragma unroll
    for (int j = 0; j < 4; ++j) { const int n = (lane >> 3) + 8 * j; const LAS float* s = scr + (8 * c) * 33 + n;
        v4u o; o.x = pk(s[0 * 33], s[1 * 33]); o.y = pk(s[2 * 33], s[3 * 33]); o.z = pk(s[4 * 33], s[5 * 33]); o.w = pk(s[6 * 33], s[7 * 33]);
        *(v4u*)(WT + (size_t)(nd0 + n) * K + k0 + 8 * c) = o; }
    LDS_WAIT(); asm volatile("" ::: "memory");
}

__device__ __forceinline__ void phase0(const Args& a, LAS unsigned char* lds, int tid, int lane, int wave, int G) {
    unsigned char* ws = a.ws;
    LAS float* scr = (LAS float*)(lds + wave * 16384);
    const int gw = blockIdx.x * 8 + wave, NGW = G * 8;
    constexpr int I_IN = 32 * 352, I_GU = 32 * 176, I_D = 88 * 64, I_SQ = 32 * 64, I_A = 16 * 64, I_P = 4 * 4 * 8;
    constexpr int NITEMS = I_IN + 2 * I_GU + I_D + 2 * I_SQ + I_A + I_P;
    for (int it = gw; it < NITEMS; it += NGW) {
        int r = it;
        if (r < I_IN) { const int kb = r / 352, nb = r % 352, nd0 = 32 * nb, ns0 = nd0 < 5120 ? nd0 : nd0 + 16;
            transpose_item(a.in[2], DIN, D, 64 * kb, ns0, (bf16*)(ws + WS_WIN), nd0, scr, lane); continue; } r -= I_IN;
        if (r < I_GU) { const int kb = r / 176, nb = r % 176, c = 32 * nb, nd0 = (c >> 7) * 256 + (c & 127);
            transpose_item(a.in[14], FF, D, 64 * kb, c, (bf16*)(ws + WS_WGU), nd0, scr, lane); continue; } r -= I_GU;
        if (r < I_GU) { const int kb = r / 176, nb = r % 176, c = 32 * nb, nd0 = (c >> 7) * 256 + (c & 127) + 128;
            transpose_item(a.in[15], FF, D, 64 * kb, c, (bf16*)(ws + WS_WGU), nd0, scr, lane); continue; } r -= I_GU;
        if (r < I_D) { const int kb = r / 64, nb = r % 64;
            transpose_item(a.in[16], D, FF, 64 * kb, 32 * nb, (bf16*)(ws + WS_WD), 32 * nb, scr, lane); continue; } r -= I_D;
        if (r < I_SQ) { const int kb = r / 64, nb = r % 64;
            transpose_item(a.in[9], D, D, 64 * kb, 32 * nb, (bf16*)(ws + WS_WB), 32 * nb, scr, lane); continue; } r -= I_SQ;
        if (r < I_SQ) { const int kb = r / 64, nb = r % 64;
            transpose_item(a.in[11], D, D, 64 * kb, 32 * nb, (bf16*)(ws + WS_WOUT), 32 * nb, scr, lane); continue; } r -= I_SQ;
        if (r < I_A) { const int kb = r / 64, nb = r % 64;
            transpose_item(a.in[8], D, PW, 64 * kb, 32 * nb, (bf16*)(ws + WS_WA), 32 * nb, scr, lane); continue; } r -= I_A;
        { const int g = r / 32, rr = r % 32, kb = rr / 8, nb = rr % 8;
            transpose_item(a.in[5] + (size_t)g * 65536, 256, 256, 64 * kb, 32 * nb, (bf16*)(ws + WS_WP) + (size_t)g * 65536, 32 * nb, scr, lane); }
    }
    __syncthreads();
    LAS float* wgt = (LAS float*)lds;
    for (int e = tid; e < 2048 * 4; e += 512) { const int k = e >> 2, q4 = e & 3; const f32x4 v = *(const f32x4*)(a.in[2] + (size_t)k * DIN + 5120 + 4 * q4);
        wgt[(4 * q4 + 0) * 2048 + k] = v[0]; wgt[(4 * q4 + 1) * 2048 + k] = v[1]; wgt[(4 * q4 + 2) * 2048 + k] = v[2]; wgt[(4 * q4 + 3) * 2048 + k] = v[3]; }
    __syncthreads();
    f32x4 gn[8];
#pragma unroll
    for (int j = 0; j < 8; ++j) gn[j] = *(const f32x4*)(a.in[1] + 256 * j + 4 * lane);
    bf16* XN = (bf16*)(ws + WS_XN); float* glr = (float*)(ws + WS_GLR);
    typedef float f32x2 __attribute__((ext_vector_type(2)));
    f32x4 na[8], nb[8];
    if (gw < M / 2) {
#pragma unroll
        for (int j = 0; j < 8; ++j) { na[j] = *(const f32x4*)(a.in[0] + (size_t)(2 * gw) * D + 256 * j + 4 * lane); nb[j] = *(const f32x4*)(a.in[0] + (size_t)(2 * gw + 1) * D + 256 * j + 4 * lane); }
    }
    const int hi = lane >> 5;
    for (int pr = gw; pr < M / 2; pr += NGW) {
        const size_t ra = 2 * (size_t)pr, rb = ra + 1;
        f32x2 xab[8][4]; float ssa = 0.f, ssb = 0.f;
#pragma unroll
        for (int j = 0; j < 8; ++j) {
            const f32x4 va = na[j], vb = nb[j];
            ssa += (va[0] * va[0] + va[1] * va[1]) + (va[2] * va[2] + va[3] * va[3]); ssb += (vb[0] * vb[0] + vb[1] * vb[1]) + (vb[2] * vb[2] + vb[3] * vb[3]);
#pragma unroll
            for (int i = 0; i < 4; ++i) xab[j][i] = (f32x2){va[i] * gn[j][i], vb[i] * gn[j][i]}; }
        { const int nx = (pr + NGW < M / 2) ? pr + NGW : pr;
#pragma unroll
          for (int j = 0; j < 8; ++j) { na[j] = *(const f32x4*)(a.in[0] + (size_t)(2 * nx) * D + 256 * j + 4 * lane); nb[j] = *(const f32x4*)(a.in[0] + (size_t)(2 * nx + 1) * D + 256 * j + 4 * lane); } }
        const float rsa = rsqrtf(wave_sum(ssa) * (1.f / D) + EPS), rsb = rsqrtf(wave_sum(ssb) * (1.f / D) + EPS);
#pragma unroll
        for (int j = 0; j < 8; ++j) { v2u wa, wb; wa.x = pk(xab[j][0].x * rsa, xab[j][1].x * rsa); wa.y = pk(xab[j][2].x * rsa, xab[j][3].x * rsa); wb.x = pk(xab[j][0].y * rsb, xab[j][1].y * rsb); wb.y = pk(xab[j][2].y * rsb, xab[j][3].y * rsb);
            *(v2u*)(XN + ra * D + 256 * j + 4 * lane) = wa; *(v2u*)(XN + rb * D + 256 * j + 4 * lane) = wb; }
        float v[16];
#pragma unroll
        for (int jj = 0; jj < 16; ++jj) { f32x2 s0 = {0.f, 0.f}, s1 = {0.f, 0.f};
#pragma unroll
            for (int j = 0; j < 8; ++j) { const f32x4 w = *(const LAS f32x4*)(wgt + jj * 2048 + 256 * j + 4 * lane);
                s0 = xab[j][0] * w[0] + s0; s1 = xab[j][1] * w[1] + s1; s0 = xab[j][2] * w[2] + s0; s1 = xab[j][3] * w[3] + s1; }
            s0 = s0 + s1;
            const float mine = hi ? s0.y : s0.x, send = hi ? s0.x : s0.y;
            v[jj] = mine + __shfl_xor(send, 32); }
#pragma unroll
        for (int st = 0; st < 4; ++st) { const int n = 8 >> st, msk = 16 >> st; const bool b = (lane & msk) != 0;
#pragma unroll
            for (int i = 0; i < n; ++i) { const float mine = b ? v[i + n] : v[i], send = b ? v[i] : v[i + n]; v[i] = mine + __shfl_xor(send, msk); } }
        v[0] += __shfl_xor(v[0], 1);
        if ((lane & 1) == 0) glr[(ra + hi) * 16 + ((lane >> 1) & 15)] = v[0] * (hi ? rsb : rsa);
    }
}

template <int W> __device__ __forceinline__ void pool_block(const bf16* P, bf16* Dd, int tblk, int c8) {
    const int t0 = tblk * 8, pos0 = t0 & (T - 1);
    constexpr int R = W + 7;
    v4u rows[R];
#pragma unroll
    for (int r = 0; r < R; ++r) { const int dt = r - (W - 1); const bool valid = (pos0 + dt) >= 0;
        rows[r] = valid ? *(const v4u*)(P + (size_t)(t0 + dt) * 1024 + c8 * 8) : (v4u){0u, 0u, 0u, 0u}; }
    float s[8];
#pragma unroll
    for (int i = 0; i < 8; ++i) s[i] = 0.f;
#pragma unroll
    for (int r = 0; r < W - 1; ++r) { float f[8]; unpack8(rows[r], f);
#pragma unroll
        for (int i = 0; i < 8; ++i) s[i] += f[i]; }
#pragma unroll
    for (int o = 0; o < 8; ++o) {
        float cur[8]; unpack8(rows[o + W - 1], cur);
#pragma unroll
        for (int i = 0; i < 8; ++i) s[i] += cur[i];
        const int cnt = (pos0 + o + 1 < W) ? pos0 + o + 1 : W; const float inv = __builtin_amdgcn_rcpf((float)cnt);
        float d[8];
#pragma unroll
        for (int i = 0; i < 8; ++i) d[i] = s[i] * inv - cur[i];
        *(v4u*)(Dd + (size_t)(t0 + o) * 1024 + c8 * 8) = pack8(d);
        float old[8]; unpack8(rows[o], old);
#pragma unroll
        for (int i = 0; i < 8; ++i) s[i] -= old[i];
    }
}
__device__ __forceinline__ void pool_diff(const bf16* P, bf16* Dd, int lane, int wave, int G) {
    const int gw = blockIdx.x * 8 + wave, NGW = G * 8;
    for (int wi = gw; wi < 4 * (M / 16); wi += NGW) {
        const int g = (wi + (wi >> 11)) & 3, tp = wi >> 2, tblk = 2 * tp + (lane >> 5), c8 = g * 32 + (lane & 31);
        if (g == 0) pool_block<2>(P, Dd, tblk, c8); else if (g == 1) pool_block<4>(P, Dd, tblk, c8); else if (g == 2) pool_block<8>(P, Dd, tblk, c8); else pool_block<16>(P, Dd, tblk, c8);
    }
}

__device__ __forceinline__ void gla_prepass(const Args& a, LAS unsigned char* lds, int tid, int lane, int wave, int G) {
    unsigned char* ws = a.ws;
    constexpr int QS = 0, KS = 33792, WU = 67584;
    const bf16* Q = (const bf16*)(ws + Z_Q); bf16* Qp = (bf16*)(ws + WS_QP); const bf16* Kb = (const bf16*)(ws + Z_K); bf16* KdT = (bf16*)(ws + WS_KDT);
    bf16* Amat = (bf16*)((unsigned char*)a.out + DO_AMAT); float* avec = (float*)((unsigned char*)a.out + DO_AVEC);
    const float* glr = (const float*)(ws + WS_GLR);
    const int l15 = lane & 15, g4 = lane >> 4;
    for (int it = blockIdx.x; it < 2048; it += G) {
        const int bh = it >> 7, c = it & 127, b = bh >> 2, h = bh & 3; const size_t t0 = (size_t)b * T + (size_t)c * 64;
        const size_t trow = t0 + lane; const int kc0 = h * 256 + 32 * wave;
        f32x4 gl[4];
#pragma unroll
        for (int i = 0; i < 4; ++i) gl[i] = *(const f32x4*)(glr + trow * 16 + 4 * i);
        v4u qv[4], kv[4];
#pragma unroll
        for (int i = 0; i < 4; ++i) { qv[i] = *(const v4u*)(Q + trow * 1024 + kc0 + 8 * i); kv[i] = *(const v4u*)(Kb + trow * 1024 + kc0 + 8 * i); }
        for (int e = tid; e < 17 * 64; e += 512) { const int jr = e >> 6, c4 = (e & 63) * 4;
            const f32x4 v = (jr < 16) ? *(const f32x4*)(a.in[3] + jr * 1024 + h * 256 + c4) : *(const f32x4*)(a.in[4] + h * 256 + c4);
            *(LAS f32x4*)(lds + WU + (jr * 256 + c4) * 4) = v; }
        __syncthreads();
        float Gc[32];
#pragma unroll
        for (int q8 = 0; q8 < 8; ++q8) {
            f32x4 z = *(const LAS f32x4*)(lds + WU + (16 * 256 + 32 * wave + 4 * q8) * 4);
#pragma unroll
            for (int jr = 0; jr < 16; ++jr) { const f32x4 w = *(const LAS f32x4*)(lds + WU + (jr * 256 + 32 * wave + 4 * q8) * 4); z = z + w * gl[jr >> 2][jr & 3]; }
#pragma unroll
            for (int i = 0; i < 4; ++i) { const float zz = z[i]; Gc[4 * q8 + i] = (fminf(zz, 0.f) - __logf(1.f + __expf(-fabsf(zz)))) * 0.0625f; }
        }
#pragma unroll
        for (int d = 1; d < 64; d <<= 1) {
#pragma unroll
            for (int cc = 0; cc < 32; ++cc) { const float up = __shfl_up(Gc[cc], d); Gc[cc] += (lane >= d) ? up : 0.f; } }
        float kd[32]; unsigned qpk[16], kpk[16];
#pragma unroll
        for (int i = 0; i < 4; ++i) { float qf[8], kf[8]; unpack8(qv[i], qf); unpack8(kv[i], kf);
#pragma unroll
            for (int e = 0; e < 8; ++e) { const int cc = 8 * i + e; const float Gv = Gc[cc], Gl = __shfl(Gv, 63);
                const float eg = __expf(Gv), ie = __expf(-Gv);
                qf[e] = qf[e] * eg; kd[cc] = kf[e] * __expf(Gl - Gv); kf[e] = kf[e] * ie;
                if (lane == 63) Gc[cc] = eg; }
            const v4u qo = pack8(qf), ko = pack8(kf);
            *(v4u*)(Qp + trow * 1024 + kc0 + 8 * i) = qo;
            *(LAS v4u*)(lds + QS + lane * 528 + (32 * wave + 8 * i) * 2) = qo; *(LAS v4u*)(lds + KS + lane * 528 + (32 * wave + 8 * i) * 2) = ko; }
        if (lane == 63) {
#pragma unroll
            for (int i = 0; i < 8; ++i) *(f32x4*)(avec + (size_t)it * 256 + 32 * wave + 4 * i) = (f32x4){Gc[4 * i], Gc[4 * i + 1], Gc[4 * i + 2], Gc[4 * i + 3]}; }
#pragma unroll
        for (int cc = 0; cc < 32; cc += 2) { const unsigned p2 = pk(kd[cc], kd[cc + 1]);
            KdT[((size_t)it * 256 + 32 * wave + cc) * 64 + lane] = (unsigned short)(p2 & 0xffffu); KdT[((size_t)it * 256 + 32 * wave + cc + 1) * 64 + lane] = (unsigned short)(p2 >> 16); }
        __syncthreads();
        const int jt = wave >> 1, it0 = 2 * (wave & 1);
        f32x4 c0 = {0.f, 0.f, 0.f, 0.f}, c1 = c0;
#pragma unroll
        for (int kk = 0; kk < 8; ++kk) {
            const bf16x8 av = *(const LAS bf16x8*)(lds + KS + (16 * jt + l15) * 528 + (32 * kk + 8 * g4) * 2);
            const bf16x8 b0 = *(const LAS bf16x8*)(lds + QS + (16 * it0 + l15) * 528 + (32 * kk + 8 * g4) * 2);
            const bf16x8 b1 = *(const LAS bf16x8*)(lds + QS + (16 * it0 + 16 + l15) * 528 + (32 * kk + 8 * g4) * 2);
            c0 = __builtin_amdgcn_mfma_f32_16x16x32_bf16(av, b0, c0, 0, 0, 0); c1 = __builtin_amdgcn_mfma_f32_16x16x32_bf16(av, b1, c1, 0, 0, 0); }
        { const int jb = 16 * jt + 4 * g4; const int i0 = 16 * it0 + l15, i1 = i0 + 16;
          v2u w0, w1;
          w0.x = pk(jb + 0 <= i0 ? c0[0] : 0.f, jb + 1 <= i0 ? c0[1] : 0.f); w0.y = pk(jb + 2 <= i0 ? c0[2] : 0.f, jb + 3 <= i0 ? c0[3] : 0.f);
          w1.x = pk(jb + 0 <= i1 ? c1[0] : 0.f, jb + 1 <= i1 ? c1[1] : 0.f); w1.y = pk(jb + 2 <= i1 ? c1[2] : 0.f, jb + 3 <= i1 ? c1[3] : 0.f);
          *(v2u*)(Amat + (size_t)it * 4096 + i0 * 64 + jb) = w0; *(v2u*)(Amat + (size_t)it * 4096 + i1 * 64 + jb) = w1; }
        __syncthreads();
    }
}

__device__ __forceinline__ void gla_seq(const Args& a, LAS unsigned char* lds, int tid, int lane, int wave, int G, int vc) {
    unsigned char* ws = a.ws;
    constexpr int QS0 = 0, QS1 = 33792, AS0 = 67584, AS1 = 76800, VT0 = 86016, VT1 = 90624, ST0 = 95232, ST1 = 112128;
    const bf16* Q = (const bf16*)(ws + WS_QP); const bf16* KdT = (const bf16*)(ws + WS_KDT); const bf16* V = (const bf16*)(ws + Z_V); bf16* Ob = (bf16*)((unsigned char*)a.out + DO_O);
    const bf16* Amat = (const bf16*)((unsigned char*)a.out + DO_AMAT); const float* avec = (const float*)((unsigned char*)a.out + DO_AVEC);
    const int l15 = lane & 15, g4 = lane >> 4, nt_o = wave & 1, itl = wave >> 1;
    for (int it = vc; it < 256; it += G) {
        const int vi = (it & 7) * 32 + (it >> 3), bh = vi >> 4, vs = vi & 15, b = bh >> 2, h = bh & 3;
        const size_t tb = (size_t)b * T;
        const bf16* qbase = Q + tb * 1024 + h * 256;
        const bf16* ktbase = KdT + (size_t)bh * 128 * 16384;
        const bf16* abase = Amat + (size_t)bh * 128 * 4096;
        const float* avbase = avec + (size_t)bh * 128 * 256;
        const bf16* vbase = V + tb * 2048 + h * 512 + vs * 32; bf16* obase = Ob + tb * 2048 + h * 512 + vs * 32;
        for (int e = tid; e < 16896 / 4; e += 512) ((LAS unsigned*)(lds + ST0))[e] = 0u;
        f32x4 sacc[2][2];
#pragma unroll
        for (int i = 0; i < 2; ++i)
#pragma unroll
            for (int j = 0; j < 2; ++j) sacc[i][j] = (f32x4){0.f, 0.f, 0.f, 0.f};
        v4u rq0[4], ra0, rq1[4], ra1, rk0[4], rk1[4]; v2u rv0, rv1; f32x4 rd0[2], rd1[2];
#define CLAMPC(cc) ((cc) < NCH ? (cc) : NCH - 1)
#define GL_COOP(cc, P) do { const int c_ = CLAMPC(cc); \
        _Pragma("unroll") for (int r = 0; r < 4; ++r) { const int e = tid + 512 * r; rq##P[r] = *(const v4u*)(qbase + (size_t)(c_ * 64 + (e >> 5)) * 1024 + (e & 31) * 8); } \
        ra##P = *(const v4u*)(abase + (size_t)c_ * 4096 + tid * 8); \
        rv##P = *(const v2u*)(vbase + (size_t)(c_ * 64 + (tid >> 3)) * 2048 + (tid & 7) * 4); } while (0)
#define GL_PRIV(cc, P) do { const int c_ = CLAMPC(cc); \
        _Pragma("unroll") for (int kt = 0; kt < 2; ++kt) { \
            _Pragma("unroll") for (int kk = 0; kk < 2; ++kk) rk##P[2 * kt + kk] = *(const v4u*)(ktbase + (size_t)c_ * 16384 + (32 * wave + 16 * kt + l15) * 64 + 32 * kk + 8 * g4); \
            rd##P[kt] = *(const f32x4*)(avbase + c_ * 256 + 32 * wave + 16 * kt + 4 * g4); } } while (0)
#define GL_TILES(P) do { \
        _Pragma("unroll") for (int r = 0; r < 4; ++r) { const int e = tid + 512 * r; *(LAS v4u*)(lds + QS##P + (e >> 5) * 528 + (e & 31) * 16) = rq##P[r]; } \
        *(LAS v4u*)(lds + AS##P + (tid >> 3) * 144 + (tid & 7) * 16) = ra##P; \
        { LAS unsigned short* vt = (LAS unsigned short*)(lds + VT##P); const int j = tid >> 3, n0 = 4 * (tid & 7); \
          vt[(n0 + 0) * 72 + j] = (unsigned short)(rv##P.x & 0xffffu); vt[(n0 + 1) * 72 + j] = (unsigned short)(rv##P.x >> 16); \
          vt[(n0 + 2) * 72 + j] = (unsigned short)(rv##P.y & 0xffffu); vt[(n0 + 3) * 72 + j] = (unsigned short)(rv##P.y >> 16); } } while (0)
#define GL_STEP(c, S, O) do { \
            GL_TILES(O);                           \
            GL_COOP((c) + 3, O); \
            { f32x4 oa = {0.f, 0.f, 0.f, 0.f}, ob = oa; \
              _Pragma("unroll") for (int kk = 0; kk < 8; kk += 2) { \
                  const bf16x8 a0 = *(const LAS bf16x8*)(lds + ST##S + (16 * nt_o + l15) * 528 + (32 * kk + 8 * g4) * 2), b0 = *(const LAS bf16x8*)(lds + QS##S + (16 * itl + l15) * 528 + (32 * kk + 8 * g4) * 2); \
                  const bf16x8 a1 = *(const LAS bf16x8*)(lds + ST##S + (16 * nt_o + l15) * 528 + (32 * kk + 32 + 8 * g4) * 2), b1 = *(const LAS bf16x8*)(lds + QS##S + (16 * itl + l15) * 528 + (32 * kk + 32 + 8 * g4) * 2); \
                  oa = __builtin_amdgcn_mfma_f32_16x16x32_bf16(a0, b0, oa, 0, 0, 0); ob = __builtin_amdgcn_mfma_f32_16x16x32_bf16(a1, b1, ob, 0, 0, 0); } \
              { const bf16x8 a0 = *(const LAS bf16x8*)(lds + VT##S + (16 * nt_o + l15) * 144 + (8 * g4) * 2), b0 = *(const LAS bf16x8*)(lds + AS##S + (16 * itl + l15) * 144 + (8 * g4) * 2); \
                const bf16x8 a1 = *(const LAS bf16x8*)(lds + VT##S + (16 * nt_o + l15) * 144 + (32 + 8 * g4) * 2), b1 = *(const LAS bf16x8*)(lds + AS##S + (16 * itl + l15) * 144 + (32 + 8 * g4) * 2); \
                oa = __builtin_amdgcn_mfma_f32_16x16x32_bf16(a0, b0, oa, 0, 0, 0); ob = __builtin_amdgcn_mfma_f32_16x16x32_bf16(a1, b1, ob, 0, 0, 0); } \
              oa = oa + ob; \
              v2u w; w.x = pk_c(oa[0], oa[1]); w.y = pk_c(oa[2], oa[3]); \
              *(v2u*)(obase + (size_t)((c) * 64 + 16 * itl + l15) * 2048 + 16 * nt_o + 4 * g4) = w; } \
            _Pragma("unroll") for (int kt = 0; kt < 2; ++kt) { \
                _Pragma("unroll") for (int nt = 0; nt < 2; ++nt) { \
                    const bf16x8 vb0 = *(const LAS bf16x8*)(lds + VT##S + (16 * nt + l15) * 144 + (8 * g4) * 2), vb1 = *(const LAS bf16x8*)(lds + VT##S + (16 * nt + l15) * 144 + (32 + 8 * g4) * 2); \
                    f32x4 sv = sacc[kt][nt] * rd##S[kt]; \
                    sv = __builtin_amdgcn_mfma_f32_16x16x32_bf16(__builtin_bit_cast(bf16x8, rk##S[2 * kt]), vb0, sv, 0, 0, 0); sv = __builtin_amdgcn_mfma_f32_16x16x32_bf16(__builtin_bit_cast(bf16x8, rk##S[2 * kt + 1]), vb1, sv, 0, 0, 0); \
                    sacc[kt][nt] = sv; } } \
            _Pragma("unroll") for (int kt = 0; kt < 2; ++kt) \
                _Pragma("unroll") for (int nt = 0; nt < 2; ++nt) { const f32x4 sv = sacc[kt][nt]; v2u w; w.x = pk_c(sv[0], sv[1]); w.y = pk_c(sv[2], sv[3]); \
                    *(LAS v2u*)(lds + ST##O + (16 * nt + l15) * 528 + (32 * wave + 16 * kt + 4 * g4) * 2) = w; }     \
            GL_PRIV((c) + 2, S); \
            BAR_LDS(); \
        } while (0)
        GL_COOP(0, 0); GL_TILES(0); GL_COOP(1, 1); GL_COOP(2, 0); GL_PRIV(0, 0); GL_PRIV(1, 1);
        BAR_LDS();
        for (int c = 0; c < NCH; c += 2) { GL_STEP(c, 0, 1); GL_STEP(c + 1, 1, 0); }
#undef CLAMPC
#undef GL_COOP
#undef GL_PRIV
#undef GL_TILES
#undef GL_STEP
        __syncthreads();
    }
}

__device__ __forceinline__ void on_pass(const Args& a, int lane, int wave, int G) {
    const bf16* O = (const bf16*)((unsigned char*)a.out + DO_O); bf16* ON = (bf16*)(a.ws + Z_V); const bf16* R = (const bf16*)(a.ws + Z_R);
    const f32x4 gA = *(const f32x4*)(a.in[7] + 8 * lane), gB = *(const f32x4*)(a.in[7] + 8 * lane + 4);
    const int gw = blockIdx.x * 8 + wave, NGW = G * 8;
    v4u ov[4], rv[4];
    if (gw < M) {
#pragma unroll
        for (int j = 0; j < 4; ++j) { ov[j] = *(const v4u*)(O + (size_t)gw * 2048 + 8 * lane + 512 * j); rv[j] = *(const v4u*)(R + (size_t)gw * 2048 + 8 * lane + 512 * j); }
    }
    for (int row = gw; row < M; row += NGW) {
        bf16* on = ON + (size_t)row * 2048 + 8 * lane;
        v4u oc[4], rc[4];
#pragma unroll
        for (int j = 0; j < 4; ++j) { oc[j] = ov[j]; rc[j] = rv[j]; }
        { const int nx = (row + NGW < M) ? row + NGW : row;
#pragma unroll
          for (int j = 0; j < 4; ++j) { ov[j] = *(const v4u*)(O + (size_t)nx * 2048 + 8 * lane + 512 * j); rv[j] = *(const v4u*)(R + (size_t)nx * 2048 + 8 * lane + 512 * j); } }
#pragma unroll
        for (int j = 0; j < 4; ++j) { float f[8], s[8]; unpack8(oc[j], f); unpack8(rc[j], s); float ss = 0.f;
#pragma unroll
            for (int i = 0; i < 8; ++i) ss += f[i] * f[i];
            const float rs = rsqrtf(wave_sum(ss) * (1.f / 512.f) + EPS);
#pragma unroll
            for (int i = 0; i < 4; ++i) { f[i] = f[i] * rs * gA[i] * s[i]; f[4 + i] = f[4 + i] * rs * gB[i] * s[4 + i]; }
            *(v4u*)(on + 512 * j) = pack8(f); }
    }
}
template <int MODE> __device__ __forceinline__ void res_pass(const float* xin, const bf16* U, const float* g1p, const float* g2p, float* out, bf16* H2, int lane, int wave, int G) {
    f32x4 g1[4][2], g2[4][2];
#pragma unroll
    for (int j = 0; j < 4; ++j)
#pragma unroll
        for (int q = 0; q < 2; ++q) { g1[j][q] = *(const f32x4*)(g1p + 512 * j + 8 * lane + 4 * q); if (MODE == 0) g2[j][q] = *(const f32x4*)(g2p + 512 * j + 8 * lane + 4 * q); }
    const int gw = blockIdx.x * 8 + wave, NGW = G * 8;
    for (int row = gw; row < M; row += NGW) {
        const size_t ro = (size_t)row * 2048 + 8 * lane;
        v4u uv[4]; f32x4 xv[4][2];
#pragma unroll
        for (int j = 0; j < 4; ++j) { uv[j] = *(const v4u*)(U + ro + 512 * j); xv[j][0] = *(const f32x4*)(xin + ro + 512 * j); xv[j][1] = *(const f32x4*)(xin + ro + 512 * j + 4); }
        float uf[4][8]; float ss = 0.f;
#pragma unroll
        for (int j = 0; j < 4; ++j) { unpack8(uv[j], uf[j]);
#pragma unroll
            for (int i = 0; i < 8; ++i) ss += uf[j][i] * uf[j][i]; }
        const float rs = rsqrtf(wave_sum(ss) * (1.f / 2048.f) + EPS);
        float s1 = 0.f;
#pragma unroll
        for (int j = 0; j < 4; ++j)
#pragma unroll
            for (int q = 0; q < 2; ++q)
#pragma unroll
                for (int i = 0; i < 4; ++i) { const float v = xv[j][q][i] + uf[j][4 * q + i] * rs * g1[j][q][i]; xv[j][q][i] = v; s1 += v * v; }
#pragma unroll
        for (int j = 0; j < 4; ++j) { *(f32x4*)(out + ro + 512 * j) = xv[j][0]; *(f32x4*)(out + ro + 512 * j + 4) = xv[j][1]; }
        if (MODE == 0) {
            const float r1 = rsqrtf(wave_sum(s1) * (1.f / 2048.f) + EPS);
#pragma unroll
            for (int j = 0; j < 4; ++j) { float f[8];
#pragma unroll
                for (int i = 0; i < 4; ++i) { f[i] = xv[j][0][i] * r1 * g2[j][0][i]; f[4 + i] = xv[j][1][i] * r1 * g2[j][1][i]; }
                *(v4u*)(H2 + ro + 512 * j) = pack8(f); }
        }
    }
}

#define XB_TMO      128
#define XB_XCNT(j)  (256  + 64 * (j))
#define XB_XSUB(j)  (1280 + 64 * (j))
#define XB_XGEN(j)  (2304 + 64 * (j))
#define XB_TOP      3328
#define XB_TOPGEN   3392
#define XCD_BAR_WORDS 3456
#define XB_SPIN_CAP (1u << 18)

__device__ __forceinline__ unsigned xb_ld(unsigned* p)              { return __hip_atomic_load(p, __ATOMIC_RELAXED, __HIP_MEMORY_SCOPE_AGENT); }
__device__ __forceinline__ unsigned xb_add(unsigned* p, unsigned v) { return __hip_atomic_fetch_add(p, v, __ATOMIC_RELAXED, __HIP_MEMORY_SCOPE_AGENT); }
__device__ __forceinline__ unsigned xb_xcc_id() { return (unsigned)__builtin_amdgcn_s_getreg((3 << 11) | 20) & 0xFu; }
#define XB_SPIN(cond, bar) do { unsigned _sp = 0; while (cond) { __builtin_amdgcn_s_sleep(1); \
    if ((++_sp & 255u) == 0u) { if (xb_ld(&(bar)[XB_TMO])) break; if (_sp > XB_SPIN_CAP) { atomicAdd(&(bar)[XB_TMO], 1u); break; } } } } while (0)

struct XcdBarrier {
    unsigned* bar; unsigned x;
    volatile LAS unsigned* st;
};

__device__ __forceinline__ void xcd_barrier_post(unsigned* bar, bool t0) {
    if (t0) (void)xb_add(&bar[XB_XCNT(xb_xcc_id())], 1u);
}
__device__ __forceinline__ void xcd_barrier_complete(unsigned* bar, unsigned x, unsigned& nloc, unsigned& nx) {
    const unsigned G = gridDim.x * gridDim.y * gridDim.z;
    unsigned sum, cnt, mine, sp = 0u;
    for (;;) {
        sum = 0u; cnt = 0u; mine = 0u;
#pragma unroll
        for (unsigned j = 0; j < 16; ++j) { const unsigned c = xb_ld(&bar[XB_XCNT(j)]); sum += c; cnt += (c > 0u) ? 1u : 0u; mine = (j == x) ? c : mine; }
        if (sum == G) break;
        __builtin_amdgcn_s_sleep(1);
        if ((++sp & 255u) == 0u) { if (xb_ld(&bar[XB_TMO])) break; if (sp > XB_SPIN_CAP) { atomicAdd(&bar[XB_TMO], 1u); break; } }
    }
    nloc = mine > 0u ? mine : 1u; nx = cnt > 0u ? cnt : 1u;
}

__device__ __forceinline__ void xcd_barrier(const XcdBarrier& b, const bool t0) {
    asm volatile("s_waitcnt vmcnt(0)" ::: "memory");
    __syncthreads();
    if (t0) {
        unsigned* bar = b.bar;
        __builtin_amdgcn_s_waitcnt(0);
        unsigned nloc = b.st[0], nx = b.st[1];
        if (nloc == 0u) { xcd_barrier_complete(bar, b.x, nloc, nx); b.st[0] = nloc; b.st[1] = nx; }
        const unsigned old = xb_add(&bar[XB_XSUB(b.x)], 1u);
        const unsigned gen = old / nloc;
        if (old + 1u == (gen + 1u) * nloc) {
            __builtin_amdgcn_fence(__ATOMIC_RELEASE, "agent");
            asm volatile("s_waitcnt vmcnt(0)" ::: "memory");
            const unsigned og = xb_add(&bar[XB_TOP], 1u);
            const unsigned tg = og / nx;
            if (og + 1u == (tg + 1u) * nx) xb_add(&bar[XB_TOPGEN], 1u);
            else XB_SPIN(xb_ld(&bar[XB_TOPGEN]) == tg, bar);
            __builtin_amdgcn_fence(__ATOMIC_ACQUIRE, "agent");
            xb_add(&bar[XB_XGEN(b.x)], 1u);
            asm volatile("s_waitcnt vmcnt(0)" ::: "memory");
        } else {
            XB_SPIN(xb_ld(&bar[XB_XGEN(b.x)]) == gen, bar);
            __builtin_amdgcn_fence(__ATOMIC_ACQUIRE, "agent");
            asm volatile("s_waitcnt vmcnt(0)" ::: "memory");
        }
    }
    __syncthreads();
}

#ifndef PH_MASK
#define PH_MASK 0xffff
#endif
#define PH(n) ((PH_MASK >> (n)) & 1)
#ifndef DBL_MASK
#define DBL_MASK 0x0
#endif
#define REP(k) (((DBL_MASK >> (k)) & 1) ? 2 : 1)
#define RUN(k, ...) for (int rep_ = 0; rep_ < REP(k); ++rep_) { if (rep_) { __syncthreads(); grid.sync(); } __VA_ARGS__ }
typedef const __attribute__((address_space(4))) Args* ArgsP;
__device__ __forceinline__ ArgsP get_args() { ArgsP p = (ArgsP)__builtin_amdgcn_kernarg_segment_ptr(); asm volatile("" : "+s"(p)); return p; }
__global__ void __launch_bounds__(512, 2) fwd_kernel(Args a_unused) {
    extern __shared__ __attribute__((aligned(16))) unsigned char lds_raw[];
    LAS unsigned char* lds = (LAS unsigned char*)lds_raw;
    cg::grid_group grid = cg::this_grid();
    const int wave_s = __builtin_amdgcn_readfirstlane(threadIdx.x >> 6); int tid, lane, wave; const int G = gridDim.x;
#define LAUNDER() do { unsigned m_ = ~0u; int w_ = wave_s; asm volatile("" : "+s"(m_), "+s"(w_)); lane = (int)__builtin_amdgcn_mbcnt_hi(m_, __builtin_amdgcn_mbcnt_lo(m_, 0u)); wave = w_; tid = (wave << 6) | lane; } while (0)
    { ArgsP ap0 = get_args(); unsigned* ctl = (unsigned*)(ap0->ws + WS_CTL);
      if (threadIdx.x == 0) { const unsigned xcc = (unsigned)__builtin_amdgcn_s_getreg((3 << 11) | 20) & 0xFu; const unsigned rank = atomicAdd(ctl + 64 * (xcc & 7u), 1u);
          volatile LAS unsigned* lc = (volatile LAS unsigned*)(lds + LDS_CTL); lc[0] = xcc; lc[1] = rank; lc[2] = blockIdx.x; lc[8] = 0u; lc[9] = 0u; }
      xcd_barrier_post((unsigned*)(ap0->ws + WS_CTL + CTL_BAR_OFF), threadIdx.x == 0); }
#define GRID_BAR() do { XcdBarrier xb_; xb_.bar = (unsigned*)(get_args()->ws + WS_CTL + CTL_BAR_OFF); xb_.x = xb_xcc_id(); xb_.st = (volatile LAS unsigned*)(lds + LDS_CTL) + 8; xcd_barrier(xb_, wave_s == 0 && __builtin_amdgcn_mbcnt_hi(~0u, __builtin_amdgcn_mbcnt_lo(~0u, 0u)) == 0u); } while (0)
#define PHASE_ARGS() ArgsP ap_ = get_args(); Args a; _Pragma("unroll") for (int i_ = 0; i_ < 18; ++i_) a.in[i_] = ap_->in[i_]; a.out = ap_->out; a.ws = ap_->ws; unsigned char* const ws = a.ws; (void)ws; const int vc = __builtin_amdgcn_readfirstlane((int)((volatile LAS unsigned*)(lds + LDS_CTL))[2]); (void)vc
    typedef pg8::StaticOrder SO;
#if PH(0)
    LAUNDER();
    { PHASE_ARGS();
    RUN(0, phase0(a, lds, tid, lane, wave, G); )
    }
#endif
    grid.sync();
    { ArgsP ap0 = get_args(); unsigned* ctl = (unsigned*)(ap0->ws + WS_CTL);
      if (threadIdx.x == 0) { volatile LAS unsigned* lc = (volatile LAS unsigned*)(lds + LDS_CTL); bool ok = (G % 8) == 0;
          for (int x = 0; x < 8; ++x) ok = ok && (__hip_atomic_load(ctl + 64 * x, __ATOMIC_RELAXED, __HIP_MEMORY_SCOPE_AGENT) == (unsigned)(G / 8));
          const unsigned xcc = lc[0], rank = lc[1]; lc[2] = (ok && xcc < 8u) ? xcc + 8u * rank : blockIdx.x; }
      __syncthreads(); }
#if PH(1)
    LAUNDER();
    { PHASE_ARGS();
    RUN(1, { pg8::Gemm g{(const bf16*)(ws + WS_XN), (const bf16*)(ws + WS_WIN), D, D, D, 0}; SO S; S.init(M, NZ, G, vc);
      Epi<E_Z> E{}; E.vec = a.in[10]; E.zP = (bf16*)(ws + Z_P); E.zQ = (bf16*)(ws + Z_Q); E.zK = (bf16*)(ws + Z_K); E.zV = (bf16*)(ws + Z_V); E.zR = (bf16*)(ws + Z_R); E.zG = (bf16*)(ws + Z_G);
      pg8::gemm_phase<Epi<E_Z>, SO, true, true>(lds, g, S, E, tid); } )
    }
#endif
    GRID_BAR();
#if PH(2)
    LAUNDER();
    { PHASE_ARGS();
    RUN(2, pool_diff((const bf16*)(ws + Z_P), (bf16*)((unsigned char*)a.out + DO_DIFF), lane, wave, G); )
    RUN(3, gla_prepass(a, lds, tid, lane, wave, G); )
    }
#endif
    GRID_BAR();
#if PH(3)
    LAUNDER();
    { PHASE_ARGS();
    RUN(4, gla_seq(a, lds, tid, lane, wave, G, vc); )
    RUN(5, { pg8::Gemm g{(const bf16*)((unsigned char*)a.out + DO_DIFF), (const bf16*)(ws + WS_WP), PW, 256, 256, 512}; SO S; S.init(M, PW, G, vc);
      Epi<E_POOL> E{}; E.O = (bf16*)(ws + Z_P); E.ldc = PW; E.vec = a.in[6];
      pg8::gemm_phase<Epi<E_POOL>, SO, true, true>(lds, g, S, E, tid); } )
    }
#endif
    GRID_BAR();
#if PH(4)
    LAUNDER();
    { PHASE_ARGS();
    RUN(6, on_pass(a, lane, wave, G); )
    RUN(7, { pg8::Gemm g{(const bf16*)(ws + Z_P), (const bf16*)(ws + WS_WA), PW, PW, PW, 0}; SO S; S.init(M, D, G, vc);
      Epi<E_YA> E{}; E.O = (bf16*)(ws + WS_T); E.ldc = D; E.Gt = (const bf16*)(ws + Z_G);
      pg8::gemm_phase<Epi<E_YA>, SO, true, true>(lds, g, S, E, tid); } )
    }
#endif
    GRID_BAR();
#if PH(5)
    LAUNDER();
    { PHASE_ARGS();
    RUN(8, { pg8::Gemm g{(const bf16*)(ws + Z_V), (const bf16*)(ws + WS_WB), D, D, D, 0}; SO S; S.init(M, D, G, vc);
      Epi<E_YB> E{}; E.O = (bf16*)(ws + WS_MIX); E.Tin = (const bf16*)(ws + WS_T); E.ldc = D; E.Gt = (const bf16*)(ws + Z_G) + 2048;
      pg8::gemm_phase<Epi<E_YB>, SO, true, true>(lds, g, S, E, tid); } )
    }
#endif
    GRID_BAR();
#if PH(6)
    LAUNDER();
    { PHASE_ARGS();
    RUN(9, { pg8::Gemm g{(const bf16*)(ws + WS_MIX), (const bf16*)(ws + WS_WOUT), D, D, D, 0}; SO S; S.init(M, D, G, vc);
      Epi<E_PLAIN> E{}; E.O = (bf16*)(ws + WS_U); E.ldc = D;
      pg8::gemm_phase<Epi<E_PLAIN>, SO, true, true>(lds, g, S, E, tid); } )
    }
#endif
    GRID_BAR();
#if PH(7)
    LAUNDER();
    { PHASE_ARGS();
    RUN(10, res_pass<0>(a.in[0], (const bf16*)(ws + WS_U), a.in[12], a.in[13], a.out, (bf16*)(ws + WS_H2), lane, wave, G); )
    }
#endif
    GRID_BAR();
#if PH(8)
    LAUNDER();
    { PHASE_ARGS();
    RUN(11, { pg8::Gemm g{(const bf16*)(ws + WS_H2), (const bf16*)(ws + WS_WGU), D, D, D, 0}; SO S; S.init(M, NGU, G, vc);
      Epi<E_SWIGLU> E{}; E.O = (bf16*)(ws + WS_F); E.ldc = FF;
      pg8::gemm_phase<Epi<E_SWIGLU>, SO, true, true>(lds, g, S, E, tid); } )
    }
#endif
    GRID_BAR();
#if PH(9)
    LAUNDER();
    { PHASE_ARGS();
    RUN(12, { pg8::Gemm g{(const bf16*)(ws + WS_F), (const bf16*)(ws + WS_WD), FF, FF, FF, 0}; SO S; S.init(M, D, G, vc);
      Epi<E_PLAIN> E{}; E.O = (bf16*)(ws + WS_FO); E.ldc = D;
      pg8::gemm_phase<Epi<E_PLAIN>, SO, true, true>(lds, g, S, E, tid); } )
    }
#endif
    GRID_BAR();
#if PH(10)
    LAUNDER();
    { PHASE_ARGS();
    res_pass<1>(a.out, (const bf16*)(ws + WS_FO), a.in[17], nullptr, a.out, nullptr, lane, wave, G);
    }
#endif
}

extern "C" void kernel_launch(void* const* d_in, const int* in_sizes, int n_in, void* d_out, int out_size, void* d_ws, size_t ws_size, hipStream_t stream) {
    static int grid = 0;
    if (grid == 0) {
        if (n_in != 18 || in_sizes[0] != M * D || out_size != M * D || ws_size < WS_NEED) {
            fprintf(stderr, "kernel_launch: unexpected shapes (n_in %d in0 %d out %d ws %zu need %zu)\n", n_in, n_in > 0 ? in_sizes[0] : -1, out_size, ws_size, (size_t)WS_END); grid = -1; return; }
        int dev = 0, cus = 0, per_cu = 0;
        hipGetDevice(&dev); hipDeviceGetAttribute(&cus, hipDeviceAttributeMultiprocessorCount, dev);
        hipFuncSetAttribute((const void*)fwd_kernel, hipFuncAttributeMaxDynamicSharedMemorySize, LDS_BYTES);
        if (hipOccupancyMaxActiveBlocksPerMultiprocessor(&per_cu, (const void*)fwd_kernel, 512, LDS_BYTES) != hipSuccess || per_cu < 1) per_cu = 1;
        (void)hipGetLastError();
        grid = cus * per_cu;
    }
    if (grid < 0) return;
    (void)hipMemsetAsync((unsigned char*)d_ws + WS_CTL, 0, CTL_BYTES, stream);
    Args a{};
    for (int i = 0; i < 18; ++i) a.in[i] = (const float*)d_in[i];
    a.out = (float*)d_out; a.ws = (unsigned char*)d_ws;
    void* args[] = {&a};
    hipError_t e = hipLaunchCooperativeKernel((const void*)fwd_kernel, dim3(grid), dim3(512), args, LDS_BYTES, stream);
    if (e != hipSuccess) fprintf(stderr, "cooperative launch failed: %s (grid %d)\n", hipGetErrorString(e), grid);
}
```
